# Optimizing an MI355X kernel written in HIP

```python
import math
import jax, jax.numpy as jnp
from jax import lax
import numpy as np

D_MODEL = 2048
BATCH = 16
SEQ = 256
DEPTH = 1
DEC_BATCH = 4
DEC_SEQ = 2048
PAST_LEN = 512

GRID_W = 64
D_MIX = D_MODEL
D_HY = D_MIX // 2
HY_ORDER = 2
HY_SHORT = 3
HY_BANDS = 16
HY_EMB_DIM = 1 + 2 * HY_BANDS
HY_FILTER_HIDDEN = 64
HY_SIN_FREQ = 1.0
HY_WINDOW_SHIFT = 0.05
HY_DECAY_MIN = 3.07
HY_DECAY_MAX = 15.35
D_GDN = D_MIX - D_HY
GDN_HEADS = 8
GDN_DK = D_GDN // GDN_HEADS
GDN_DV = D_GDN // GDN_HEADS
GDN_SHORT = 3
GDN_CHUNK = 64
W_IN_COLS = 3 * D_HY + 4 * D_GDN + 4 * GDN_HEADS
D_FF = 5632
N_MOD = 9
RMS_EPS = 1e-6
POS_BASE = 10000.0

kernel_name = 'hyena_gdn_macaron_prefix_flow_step'


def rms_norm(x, g):
    xf = x.astype(jnp.float32)
    y = xf * lax.rsqrt(jnp.mean(xf * xf, axis=-1, keepdims=True) + RMS_EPS)
    return (y * g.astype(jnp.float32)).astype(x.dtype)


def l2_norm(x):
    return x * lax.rsqrt(jnp.sum(x * x, axis=-1, keepdims=True) + RMS_EPS)


def adaln(x, g, shift, scale):
    return rms_norm(x, g) * (1.0 + scale) + shift


def swiglu(h, wg, wu, wd):
    return (jax.nn.silu(h @ wg) * (h @ wu)) @ wd


def dw_conv_centred(u, w):
    k = w.shape[0]
    p = k // 2
    n = u.shape[1]
    up = jnp.pad(u, ((0, 0), (p, p), (0, 0)))
    out = up[:, 0:n, :] * w[0]
    for j in range(1, k):
        out = out + up[:, j:j + n, :] * w[j]
    return out


def grid_pos_embed(n_tok, dim):
    rows = n_tok // GRID_W
    r = jnp.broadcast_to(jnp.arange(rows, dtype=jnp.float32)[:, None], (rows, GRID_W)).reshape(-1)
    col = jnp.broadcast_to(jnp.arange(GRID_W, dtype=jnp.float32)[None, :], (rows, GRID_W)).reshape(-1)
    quarter = dim // 4
    omega = 1.0 / (POS_BASE ** (jnp.arange(quarter, dtype=jnp.float32) / quarter))
    ar = r[:, None] * omega[None]
    ac = col[:, None] * omega[None]
    return jnp.concatenate([jnp.sin(ar), jnp.cos(ar), jnp.sin(ac), jnp.cos(ac)], axis=-1)


def hyena_filter_spectra(n_tok, w1, b1, w2, b2, w3, decay):
    f32 = jnp.float32
    idx = jnp.arange(n_tok, dtype=f32)
    t = idx / (n_tok - 1)
    bands = jnp.arange(1, HY_BANDS + 1, dtype=f32)
    ang = (2.0 * math.pi / n_tok) * idx[:, None] * bands[None, :]
    feats = jnp.concatenate([t[:, None], jnp.cos(ang), jnp.sin(ang)], axis=-1)
    h = jnp.sin(HY_SIN_FREQ * (feats @ w1.astype(f32) + b1.astype(f32)))
    h = jnp.sin(HY_SIN_FREQ * (h @ w2.astype(f32) + b2.astype(f32)))
    h = (h @ w3.astype(f32)).reshape(n_tok, 2, HY_ORDER, D_HY)
    window = jnp.exp(-t[:, None, None] * jnp.abs(decay.astype(f32))[None]) + HY_WINDOW_SHIFT
    h = h * window[:, None]
    h_fwd = h[:, 0]
    h_bwd = h[:, 1]
    taps = jnp.concatenate([h_fwd, jnp.zeros_like(h_fwd[:1]), h_bwd[1:][::-1]], axis=0)
    taps = taps / jnp.sum(jnp.abs(taps), axis=0, keepdims=True)
    return jnp.fft.rfft(taps, axis=0)


def fft_long_conv(u, spec, d_bias):
    n = u.shape[1]
    uf = jnp.fft.rfft(u, n=2 * n, axis=1)
    y = jnp.fft.irfft(uf * spec[None], n=2 * n, axis=1)[:, :n]
    return y + u * d_bias


def hyena_mixer(proj, conv_w, w1, b1, w2, b2, w3, decay, d_bias):
    n = proj.shape[1]
    pc = dw_conv_centred(proj, conv_w).astype(jnp.float32)
    v, x1, x2 = jnp.split(pc, 3, axis=-1)
    spec = hyena_filter_spectra(n, w1, b1, w2, b2, w3, decay)
    d_bias = d_bias.astype(jnp.float32)
    z = x1 * fft_long_conv(v, spec[:, 0], d_bias[0])
    z = x2 * fft_long_conv(z, spec[:, 1], d_bias[1])
    return z


def chunk_gated_delta(q, k, v, g, beta, s0):
    b, n, nh, dk = q.shape
    c = GDN_CHUNK
    nc = n // c

    def chunks(t):
        t = t.reshape((b, nc, c) + t.shape[2:])
        return jnp.moveaxis(t, 3, 1)

    q, k, v, g, beta = chunks(q), chunks(k), chunks(v), chunks(g), chunks(beta)
    g_cum = jnp.cumsum(g, axis=-1)
    diff = g_cum[..., :, None] - g_cum[..., None, :]
    causal = jnp.tril(jnp.ones((c, c), dtype=bool))
    strict = jnp.tril(jnp.ones((c, c), dtype=bool), -1)
    decay = jnp.where(causal, jnp.exp(jnp.where(causal, diff, 0.0)), 0.0)
    k_beta = k * beta[..., None]
    a_low = jnp.where(strict, jnp.einsum('bhnid,bhnjd->bhnij', k_beta, k) * decay, 0.0)
    t_mat = a_low + jnp.eye(c, dtype=jnp.float32)
    rhs = jnp.concatenate([v * beta[..., None], k_beta * jnp.exp(g_cum)[..., None]], axis=-1)
    sol = lax.linalg.triangular_solve(t_mat, rhs, left_side=True, lower=True, unit_diagonal=True)
    dv = v.shape[-1]
    u = sol[..., :dv]
    w = sol[..., dv:]
    attn = jnp.einsum('bhnid,bhnjd->bhnij', q, k) * decay
    g_last = g_cum[..., -1]
    k_dec = k * jnp.exp(g_last[..., None] - g_cum)[..., None]
    q_dec = q * jnp.exp(g_cum)[..., None]
    xs = tuple(jnp.moveaxis(t, 2, 0) for t in (q_dec, k_dec, u, w, attn, g_last))

    def step(s, inp):
        q_d, k_d, u_i, w_i, a_i, gl = inp
        v_new = u_i - jnp.einsum('bhck,bhkv->bhcv', w_i, s)
        o = jnp.einsum('bhck,bhkv->bhcv', q_d, s) + jnp.einsum('bhij,bhjv->bhiv', a_i, v_new)
        s = s * jnp.exp(gl)[..., None, None] + jnp.einsum('bhck,bhcv->bhkv', k_d, v_new)
        return s, o

    s_fin, o = lax.scan(step, s0, xs)
    o = jnp.transpose(o, (1, 0, 3, 2, 4)).reshape(b, n, nh, dv)
    return o, s_fin


def gdn_mixer(qkv, z, ab, conv_w, a_log, dt_bias, o_norm, s0):
    f32 = jnp.float32
    b, n, _ = qkv.shape
    qkv = jax.nn.silu(dw_conv_centred(qkv, conv_w)).astype(f32)
    q, k, v = jnp.split(qkv, 3, axis=-1)
    q = l2_norm(q.reshape(b, n, GDN_HEADS, GDN_DK)) * (GDN_DK ** -0.5)
    k = l2_norm(k.reshape(b, n, GDN_HEADS, GDN_DK))
    v = v.reshape(b, n, GDN_HEADS, GDN_DV)
    ab = ab.astype(f32).reshape(b, n, 2, 2, GDN_HEADS)
    g = -jnp.exp(a_log.astype(f32)) * jax.nn.softplus(ab[:, :, :, 0] + dt_bias.astype(f32))
    beta = jax.nn.sigmoid(ab[:, :, :, 1])
    o_f, s_f = chunk_gated_delta(q, k, v, g[:, :, 0], beta[:, :, 0], s0[:, 0])
    o_b, s_b = chunk_gated_delta(q[:, ::-1], k[:, ::-1], v[:, ::-1], g[:, ::-1, 1], beta[:, ::-1, 1], s0[:, 1])
    o = o_f + o_b[:, ::-1]
    o = rms_norm(o, o_norm) * jax.nn.silu(z.astype(f32).reshape(b, n, GDN_HEADS, GDN_DV))
    return o.reshape(b, n, D_GDN), jnp.stack([s_f, s_b], axis=1)


def trunk_layer(x, mod, s0, norm_pre, norm_post, ffn_wg, ffn_wu, ffn_wd, w_in, w_out,
                hy_conv_w, hy_f_w1, hy_f_b1, hy_f_w2, hy_f_b2, hy_f_w3, hy_decay, hy_bias, hy_out_norm,
                gdn_conv_w, gdn_a_log, gdn_dt_bias, gdn_o_norm):
    h = adaln(x, norm_pre[0], mod[:, :, 0], mod[:, :, 1])
    x = x + 0.5 * mod[:, :, 2] * rms_norm(swiglu(h, ffn_wg[0], ffn_wu[0], ffn_wd[0]), norm_post[0])

    h = adaln(x, norm_pre[1], mod[:, :, 3], mod[:, :, 4])
    proj = h @ w_in
    o0 = 3 * D_HY
    o1 = o0 + 3 * D_GDN
    o2 = o1 + D_GDN
    y_hy = rms_norm(hyena_mixer(proj[..., :o0], hy_conv_w, hy_f_w1, hy_f_b1, hy_f_w2, hy_f_b2,
                                hy_f_w3, hy_decay, hy_bias), hy_out_norm).astype(x.dtype)
    y_gdn, s_fin = gdn_mixer(proj[..., o0:o1], proj[..., o1:o2], proj[..., o2:], gdn_conv_w,
                             gdn_a_log, gdn_dt_bias, gdn_o_norm, s0)
    y = jnp.concatenate([y_hy, y_gdn.astype(x.dtype)], axis=-1) @ w_out
    x = x + mod[:, :, 5] * rms_norm(y, norm_post[1])

    h = adaln(x, norm_pre[2], mod[:, :, 6], mod[:, :, 7])
    x = x + 0.5 * mod[:, :, 8] * rms_norm(swiglu(h, ffn_wg[1], ffn_wu[1], ffn_wd[1]), norm_post[2])
    return x, s_fin


def setup_inputs(seed: int = 0) -> dict:
    key = jax.random.key(seed)
    ks = jax.random.split(key, 32)
    f32 = jnp.float32

    def nrm(k, shape, s):
        return jax.random.normal(k, shape, f32) * s

    dt = jnp.exp(jax.random.uniform(ks[25], (DEPTH, 2, GDN_HEADS), f32, math.log(1e-3), math.log(1e-1)))
    return {
        'x_prompt': nrm(ks[0], (BATCH, SEQ, D_MODEL), 1.0),
        'x_sample': nrm(ks[1], (DEC_BATCH, DEC_SEQ, D_MODEL), 1.0),
        'state_gdn': nrm(ks[2], (DEC_BATCH, DEPTH, 2, GDN_HEADS, GDN_DK, GDN_DV), GDN_DK ** -0.5),
        'c': nrm(ks[3], (DEC_BATCH, D_MODEL), 1.0),
        'c_ctx': nrm(ks[4], (D_MODEL,), 1.0),
        'ada_w': nrm(ks[5], (DEPTH, D_MODEL, N_MOD * D_MODEL), 0.5 * D_MODEL ** -0.5),
        'ada_b': nrm(ks[6], (DEPTH, N_MOD * D_MODEL), 0.02),
        'norm_pre': 1.0 + nrm(ks[7], (DEPTH, 3, D_MODEL), 0.02),
        'norm_post': 1.0 + nrm(ks[8], (DEPTH, 3, D_MODEL), 0.02),
        'ffn_wg': nrm(ks[9], (DEPTH, 2, D_MODEL, D_FF), D_MODEL ** -0.5),
        'ffn_wu': nrm(ks[10], (DEPTH, 2, D_MODEL, D_FF), D_MODEL ** -0.5),
        'ffn_wd': nrm(ks[11], (DEPTH, 2, D_FF, D_MODEL), D_FF ** -0.5),
        'w_in': nrm(ks[12], (DEPTH, D_MODEL, W_IN_COLS), D_MODEL ** -0.5),
        'w_out': nrm(ks[13], (DEPTH, D_MIX, D_MODEL), D_MIX ** -0.5),
        'hy_conv_w': nrm(ks[14], (DEPTH, HY_SHORT, 3 * D_HY), HY_SHORT ** -0.5),
        'hy_f_w1': nrm(ks[15], (DEPTH, HY_EMB_DIM, HY_FILTER_HIDDEN), HY_EMB_DIM ** -0.5),
        'hy_f_b1': nrm(ks[16], (DEPTH, HY_FILTER_HIDDEN), 0.1),
        'hy_f_w2': nrm(ks[17], (DEPTH, HY_FILTER_HIDDEN, HY_FILTER_HIDDEN), HY_FILTER_HIDDEN ** -0.5),
        'hy_f_b2': nrm(ks[18], (DEPTH, HY_FILTER_HIDDEN), 0.1),
        'hy_f_w3': nrm(ks[19], (DEPTH, HY_FILTER_HIDDEN, 2 * HY_ORDER * D_HY), HY_FILTER_HIDDEN ** -0.5),
        'hy_decay': jax.random.uniform(ks[20], (DEPTH, HY_ORDER, D_HY), f32, HY_DECAY_MIN, HY_DECAY_MAX),
        'hy_bias': nrm(ks[21], (DEPTH, HY_ORDER, D_HY), 1.0),
        'hy_out_norm': 1.0 + nrm(ks[22], (DEPTH, D_HY), 0.02),
        'gdn_conv_w': nrm(ks[23], (DEPTH, GDN_SHORT, 3 * D_GDN), GDN_SHORT ** -0.5),
        'gdn_a_log': jnp.log(jax.random.uniform(ks[24], (DEPTH, 2, GDN_HEADS), f32, 1.0, 16.0)),
        'gdn_dt_bias': dt + jnp.log(-jnp.expm1(-dt)),
        'gdn_o_norm': 1.0 + nrm(ks[26], (DEPTH, GDN_DV), 0.02),
    }


def reference(x_prompt, x_sample, state_gdn, c, c_ctx, ada_w, ada_b, norm_pre, norm_post,
              ffn_wg, ffn_wu, ffn_wd, w_in, w_out, hy_conv_w, hy_f_w1, hy_f_b1, hy_f_w2, hy_f_b2,
              hy_f_w3, hy_decay, hy_bias, hy_out_norm, gdn_conv_w, gdn_a_log, gdn_dt_bias, gdn_o_norm):
    n_ctx_req = x_prompt.shape[0]
    n_lat_req = x_sample.shape[0]
    xp = x_prompt
    xs = x_sample + grid_pos_embed(x_sample.shape[1], D_MODEL).astype(x_sample.dtype)[None]
    ctx_states = []
    for l in range(DEPTH):
        mod_ctx = (jax.nn.silu(c_ctx)[None] @ ada_w[l] + ada_b[l]).reshape(1, 1, N_MOD, D_MODEL)
        mod_lat = (jax.nn.silu(c) @ ada_w[l] + ada_b[l]).reshape(n_lat_req, 1, N_MOD, D_MODEL)
        layer_w = (norm_pre[l], norm_post[l], ffn_wg[l], ffn_wu[l], ffn_wd[l], w_in[l], w_out[l],
                   hy_conv_w[l], hy_f_w1[l], hy_f_b1[l], hy_f_w2[l], hy_f_b2[l], hy_f_w3[l], hy_decay[l],
                   hy_bias[l], hy_out_norm[l], gdn_conv_w[l], gdn_a_log[l], gdn_dt_bias[l], gdn_o_norm[l])
        s0_ctx = jnp.zeros((n_ctx_req, 2, GDN_HEADS, GDN_DK, GDN_DV), jnp.float32)
        xp, s_ctx = trunk_layer(xp, mod_ctx, s0_ctx, *layer_w)
        xs, _ = trunk_layer(xs, mod_lat, state_gdn[:, l].astype(jnp.float32), *layer_w)
        ctx_states.append(s_ctx)
    new_state_gdn = jnp.stack(ctx_states, axis=1)
    return (xp, xs, new_state_gdn)
```

```cpp
#include <hip/hip_runtime.h>
namespace pg8 {
#define PG8_LAS __attribute__((address_space(3)))
typedef unsigned short bf16_t;
typedef short bf16x8 __attribute__((ext_vector_type(8)));
typedef float f32x4 __attribute__((ext_vector_type(4)));
typedef unsigned u32x4 __attribute__((ext_vector_type(4)));
constexpr int BM = 256, BK = 64, HALF = 128, HTB = HALF * BK * 2  , STAGE_BYTES = 8 * HTB, NXCD = 8, WGM = 8;

__host__ __device__ __forceinline__ int lds_byte(int r, int c) { const int st = (r >> 4) * 2 + (c >> 5), rr = r & 15, cc = c & 31, ob = rr * 64 + cc * 2; return st * 1024 + (ob ^ (((ob >> 9) & 1) << 5)); }
__host__ __device__ __forceinline__ void stage_rc(int b, int& R, int& C) { const int st = b / 1024, sb = b % 1024, swz = sb ^ (((sb >> 9) & 1) << 5); R = (st >> 1) * 16 + swz / 64; C = (st & 1) * 32 + (swz % 64) / 2; }
__host__ __device__ __forceinline__ int perm32(int rho) { const int n = rho >> 4, i = rho & 15; return 8 * (i >> 2) + 4 * n + (i & 3); }

struct Unit { int pm, pn; };
struct Gemm { const bf16_t* A; const bf16_t* Bt; int M, N, K; };

struct StaticOrder {
    int nM, nN, nwg, G, c;
    __host__ __device__ void init(int M, int N, int G_, int c_) { nM = M / BM; nN = N / BM; nwg = nM * nN; G = G_; c = c_; }
    __host__ __device__ bool next(int i, Unit& u) const {
        const long L = (long)i * G + c; if (L >= nwg) return false;
        int wgid = (int)L; { const int q = nwg / NXCD, r = nwg % NXCD, xcd = wgid % NXCD, off = wgid / NXCD; wgid = (xcd < r ? xcd * (q + 1) : r * (q + 1) + (xcd - r) * q) + off; }
        const int nig = WGM * nN, gid = wgid / nig, fm = gid * WGM, gsz = (nM - fm) < WGM ? (nM - fm) : WGM;
        u.pm = fm + ((wgid % nig) % gsz); u.pn = (wgid % nig) / gsz; return true;
    }
    __device__ __forceinline__ void a_ready(const Unit&) const {}
    __device__ __forceinline__ void done(const Unit&) const {}
};
struct CountedOrder : StaticOrder {
    const unsigned* ready; unsigned need; unsigned* tmo;
    __device__ __forceinline__ void a_ready(const Unit& u) const {
        if (threadIdx.x < 64) {
            const unsigned long long t0 = __builtin_amdgcn_s_memrealtime(); unsigned polls = 0;
            while ((unsigned)__builtin_amdgcn_readfirstlane(__hip_atomic_load(ready + 64 * u.pm, __ATOMIC_RELAXED, __HIP_MEMORY_SCOPE_AGENT)) < need) {
                if ((++polls & 255u) == 0u && __builtin_amdgcn_readfirstlane(__hip_atomic_load(tmo, __ATOMIC_RELAXED, __HIP_MEMORY_SCOPE_AGENT)) != 0u) break;
                if (__builtin_amdgcn_s_memrealtime() - t0 > 2000000ull) {
                    if (threadIdx.x == 0) { unsigned expect = 0u; __hip_atomic_compare_exchange_strong(tmo + 1, &expect, 0x600u | (unsigned)(u.pm & 0xff), __ATOMIC_RELAXED, __ATOMIC_RELAXED, __HIP_MEMORY_SCOPE_AGENT); __hip_atomic_store(tmo, 1u, __ATOMIC_RELAXED, __HIP_MEMORY_SCOPE_AGENT); }
                    break; }
                __builtin_amdgcn_s_sleep(2); }
            __builtin_amdgcn_fence(__ATOMIC_ACQUIRE, "agent");
            asm volatile("s_waitcnt vmcnt(0)" ::: "memory");
        }
#if !defined(BROKEN_HOOK_NO_BARRIER)
        asm volatile("" ::: "memory"); __builtin_amdgcn_s_barrier(); asm volatile("" ::: "memory");
#endif
    }
};

__device__ __forceinline__ unsigned cvt_pk_bf16(float lo, float hi) { unsigned r; asm volatile("v_cvt_pk_bf16_f32 %0, %1, %2" : "=v"(r) : "v"(lo), "v"(hi)); return r; }
typedef float f32x2 __attribute__((ext_vector_type(2)));
__device__ __forceinline__ f32x2 gelu_pk(f32x2 v) {
    const f32x2 av = __builtin_elementwise_abs(v), d = av * 0.2316418882f + 1.0f;
    f32x2 t; t.x = __builtin_amdgcn_rcpf(d.x); t.y = __builtin_amdgcn_rcpf(d.y);
    f32x2 q = t * 0.5307027145f + (-0.7265760135f); q = q * t + 0.7107068705f; q = q * t + (-0.142248368f); q = q * t + 0.127414796f; q = q * t;
    const f32x2 s = (v * v) * (-0.72134752044f);
    f32x2 e; e.x = __builtin_amdgcn_exp2f(s.x); e.y = __builtin_amdgcn_exp2f(s.y);
    const f32x2 m = v * (q * e), r = v - m;
    f32x2 o; o.x = v.x < 0.f ? m.x : r.x; o.y = v.y < 0.f ? m.y : r.y; return o;
}

struct EpiF32 {
    static constexpr bool PERM = false, AFTER_DRAIN = false;
    float* C; int ldc; const float* bias;
    __device__ __forceinline__ void operator()(const f32x4 (&acc)[2][2][4][2], const Unit& u, int wr, int wc, int fr, int fq) const {
        const int row0 = u.pm * BM + wr * 64 + fr, col0 = u.pn * BM + wc * 32 + 4 * fq;
        f32x4 bv[2][2];
#pragma unroll
        for (int bj = 0; bj < 2; ++bj)
#pragma unroll
            for (int n = 0; n < 2; ++n) bv[bj][n] = bias ? *(const f32x4*)(bias + col0 + bj * HALF + n * 16) : (f32x4){0.f, 0.f, 0.f, 0.f};
#pragma unroll
        for (int ai = 0; ai < 2; ++ai)
#pragma unroll
            for (int m = 0; m < 4; ++m) { float* rowp = C + (size_t)(row0 + ai * HALF + m * 16) * ldc + col0;
#pragma unroll
                for (int bj = 0; bj < 2; ++bj)
#pragma unroll
                    for (int n = 0; n < 2; ++n) *(f32x4*)(rowp + bj * HALF + n * 16) = acc[ai][bj][m][n] + bv[bj][n]; }
    }
};
template <int ACT  > struct EpiBf16 {
    static constexpr bool PERM = true, AFTER_DRAIN = false;
    bf16_t* O; int ldc; const float* bias; int split_cols; size_t split_stride;
    __device__ __forceinline__ void operator()(const f32x4 (&acc)[2][2][4][2], const Unit& u, int wr, int wc, int fr, int fq) const {
        const int row0 = u.pm * BM + wr * 64 + fr; int colt = u.pn * BM; bf16_t* base = O;
        if (split_cols) { const int t = colt / split_cols; base += (size_t)t * split_stride; colt -= t * split_cols; }
        const int col0 = colt + wc * 32 + 8 * fq, bcol0 = u.pn * BM + wc * 32 + 8 * fq;
        f32x4 bv[2][2];
#pragma unroll
        for (int bj = 0; bj < 2; ++bj)
#pragma unroll
            for (int n = 0; n < 2; ++n) bv[bj][n] = bias ? *(const f32x4*)(bias + bcol0 + bj * HALF + 4 * n) : (f32x4){0.f, 0.f, 0.f, 0.f};
#pragma unroll
        for (int ai = 0; ai < 2; ++ai)
#pragma unroll
            for (int m = 0; m < 4; ++m) { bf16_t* rowp = base + (size_t)(row0 + ai * HALF + m * 16) * ldc + col0;
#pragma unroll
                for (int bj = 0; bj < 2; ++bj) { f32x4 v0 = acc[ai][bj][m][0] + bv[bj][0], v1 = acc[ai][bj][m][1] + bv[bj][1];
                    if (ACT == 1) { f32x2 a = gelu_pk((f32x2){v0[0], v0[1]}), b = gelu_pk((f32x2){v0[2], v0[3]}), c = gelu_pk((f32x2){v1[0], v1[1]}), d = gelu_pk((f32x2){v1[2], v1[3]});
                        v0 = (f32x4){a.x, a.y, b.x, b.y}; v1 = (f32x4){c.x, c.y, d.x, d.y}; }
                    if (ACT == 2) {
#pragma unroll
                        for (int j = 0; j < 4; ++j) { v0[j] = 0.5f * v0[j] * (1.0f + erff(v0[j] * 0.70710678f)); v1[j] = 0.5f * v1[j] * (1.0f + erff(v1[j] * 0.70710678f)); } }
                    u32x4 w; w.x = cvt_pk_bf16(v0[0], v0[1]); w.y = cvt_pk_bf16(v0[2], v0[3]); w.z = cvt_pk_bf16(v1[0], v1[1]); w.w = cvt_pk_bf16(v1[2], v1[3]);
                    *(u32x4*)(rowp + bj * HALF) = w; } }
    }
};

struct EpiSwiglu {
    static constexpr bool PERM = true, AFTER_DRAIN = false;
    bf16_t* O; int ldc;
    __device__ __forceinline__ float sg(float g, float u) const { return g * __builtin_amdgcn_rcpf(1.0f + __builtin_amdgcn_exp2f(-1.44269504089f * g)) * u; }
    __device__ __forceinline__ void operator()(const f32x4 (&acc)[2][2][4][2], const Unit& u, int wr, int wc, int fr, int fq) const {
        const int row0 = u.pm * BM + wr * 64 + fr, col0 = u.pn * HALF + wc * 32 + 8 * fq;
#pragma unroll
        for (int ai = 0; ai < 2; ++ai)
#pragma unroll
            for (int m = 0; m < 4; ++m) { bf16_t* rowp = O + (size_t)(row0 + ai * HALF + m * 16) * ldc + col0;
                const f32x4 g0 = acc[ai][0][m][0], g1 = acc[ai][0][m][1], u0 = acc[ai][1][m][0], u1 = acc[ai][1][m][1];
                u32x4 w; w.x = cvt_pk_bf16(sg(g0[0], u0[0]), sg(g0[1], u0[1])); w.y = cvt_pk_bf16(sg(g0[2], u0[2]), sg(g0[3], u0[3]));
                w.z = cvt_pk_bf16(sg(g1[0], u1[0]), sg(g1[1], u1[1])); w.w = cvt_pk_bf16(sg(g1[2], u1[2]), sg(g1[3], u1[3]));
                *(u32x4*)rowp = w; }
    }
};
template <class Epi, class Sched, bool STAMP = false>
__device__ __forceinline__ void gemm_phase(PG8_LAS unsigned char* lds, const Gemm g, const Sched& S, const Epi& E, unsigned long long* stamps) {
    const int tid = threadIdx.x, wid = __builtin_amdgcn_readfirstlane(tid >> 6), lane = tid & 63, wr = wid >> 2, wc = wid & 3, fr = lane & 15, fq = lane >> 4;
    const int K = g.K, nt = K / BK;
    int ts_lo = 0, ts_hi = 0, nts = 0; const unsigned long long rt_entry = STAMP ? (unsigned long long)wall_clock64() : 0ull;
#define PG8_STAMP() do { if (STAMP && wid == 0 && nts < 64) { const unsigned long long _c = (unsigned long long)clock64(); \
        ts_lo = (lane == nts) ? (int)(unsigned)_c : ts_lo; ts_hi = (lane == nts) ? (int)(unsigned)(_c >> 32) : ts_hi; ++nts; } } while (0)
    PG8_STAMP();
    unsigned voffA[2], voffB[2];
#pragma unroll
    for (int i = 0; i < 2; ++i) { int R, C; stage_rc(tid * 16 + i * 8192, R, C); const int Rb = Epi::PERM ? ((R & ~31) + perm32(R & 31)) : R;
        voffA[i] = (unsigned)(R * K + C) * 2u; voffB[i] = (unsigned)(Rb * K + C) * 2u; }
    const size_t kstep = (size_t)(BK * 2);
    const size_t hstep = (size_t)HALF * K * 2;
    const size_t tstep = 2 * hstep;
    const unsigned ldsw = (unsigned)wid * 1024u;
    const int aoff = lds_byte(wr * 64 + fr, fq * 8), boff = lds_byte(wc * 32 + fr, fq * 8);
#define PG8_SA(b, h) (((b) * 2 + (h)) * HTB)
#define PG8_SB(b, h) ((4 + (b) * 2 + (h)) * HTB)
#define PG8_STAGE(bufoff, gbase, voff) do { _Pragma("unroll") for (int _i = 0; _i < 2; ++_i) \
        __builtin_amdgcn_global_load_lds((const unsigned*)((const char*)(gbase) + (voff)[_i]), (PG8_LAS unsigned*)(lds + (bufoff) + ldsw + _i * 8192), 16, 0, 0); } while (0)
#define PG8_LDA(dst, b, h) do { _Pragma("unroll") for (int m = 0; m < 4; ++m) _Pragma("unroll") for (int k = 0; k < 2; ++k) dst[m][k] = *(const PG8_LAS bf16x8*)(lds + PG8_SA(b, h) + aoff + m * 2048 + k * 1024); } while (0)
#define PG8_LDB(dst, b, h) do { _Pragma("unroll") for (int n = 0; n < 2; ++n) _Pragma("unroll") for (int k = 0; k < 2; ++k) dst[n][k] = *(const PG8_LAS bf16x8*)(lds + PG8_SB(b, h) + boff + n * 2048 + k * 1024); } while (0)
#define PG8_MMA(ai, bj, At, Bt) do { __builtin_amdgcn_s_setprio(1); _Pragma("unroll") for (int m = 0; m < 4; ++m) _Pragma("unroll") for (int n = 0; n < 2; ++n) _Pragma("unroll") for (int k = 0; k < 2; ++k) \
        acc[ai][bj][m][n] = __builtin_amdgcn_mfma_f32_16x16x32_bf16(Bt[n][k], At[m][k], acc[ai][bj][m][n], 0, 0, 0); __builtin_amdgcn_s_setprio(0); } while (0)
#define PG8_WAIT_V(n) asm volatile("s_waitcnt vmcnt(" #n ")" ::: "memory")
#define PG8_WAIT_L(n) asm volatile("s_waitcnt lgkmcnt(" #n ")" ::: "memory")
#define PG8_BAR __builtin_amdgcn_s_barrier()
#define PG8_SCHED __builtin_amdgcn_sched_barrier(0)
    Unit cur, nxt; int ui = 0;
    if (!S.next(0, cur)) return;
    f32x4 acc[2][2][4][2];
#pragma unroll
    for (int a = 0; a < 2; ++a)
#pragma unroll
        for (int b = 0; b < 2; ++b)
#pragma unroll
            for (int m = 0; m < 4; ++m)
#pragma unroll
                for (int n = 0; n < 2; ++n) acc[a][b][m][n] = (f32x4){0.f, 0.f, 0.f, 0.f};
    bf16x8 At[4][2], B0[2][2], B1[2][2];
    const char* cA = (const char*)g.A + (size_t)cur.pm * tstep; const char* cB = (const char*)g.Bt + (size_t)cur.pn * tstep;
    S.a_ready(cur);
    PG8_STAGE(PG8_SB(0, 0), cB, voffB); PG8_STAGE(PG8_SA(0, 0), cA, voffA); PG8_STAGE(PG8_SB(0, 1), cB + hstep, voffB); PG8_STAGE(PG8_SA(0, 1), cA + hstep, voffA);
    if (wr == 1) PG8_BAR;
    PG8_WAIT_V(4); PG8_BAR;
    PG8_STAGE(PG8_SB(1, 0), cB + kstep, voffB); PG8_STAGE(PG8_SA(1, 0), cA + kstep, voffA); PG8_STAGE(PG8_SB(1, 1), cB + hstep + kstep, voffB);
    PG8_WAIT_V(6); PG8_BAR;
    PG8_STAMP();
    for (;;) {
        const bool has_next = S.next(ui + 1, nxt);
        const char* nA = has_next ? (const char*)g.A + (size_t)nxt.pm * tstep : cA; const char* nB = has_next ? (const char*)g.Bt + (size_t)nxt.pn * tstep : cB;
        for (int t = 0; t < nt; t += 2) {
            const bool last = (t == nt - 2);
            const char* a1 = cA + (size_t)(t + 1) * kstep;
            const char* a2 = last ? nA : cA + (size_t)(t + 2) * kstep; const char* b2 = last ? nB : cB + (size_t)(t + 2) * kstep;
            const char* a3 = a2 + kstep; const char* b3 = b2 + kstep;
            if (last && has_next) S.a_ready(nxt);
            PG8_LDB(B0, 0, 0); PG8_SCHED; PG8_LDA(At, 0, 0); PG8_STAGE(PG8_SA(1, 1), a1 + hstep, voffA);
            PG8_WAIT_L(8); PG8_BAR; PG8_WAIT_L(0); PG8_MMA(0, 0, At, B0); PG8_BAR; PG8_SCHED;
            PG8_LDB(B1, 0, 1); PG8_STAGE(PG8_SB(0, 0), b2, voffB);
            PG8_BAR; PG8_WAIT_L(0); PG8_MMA(0, 1, At, B1); PG8_BAR;
            PG8_LDA(At, 0, 1); PG8_STAGE(PG8_SA(0, 0), a2, voffA);
            PG8_BAR; PG8_WAIT_L(0); PG8_MMA(1, 0, At, B0); PG8_BAR; PG8_SCHED;
            PG8_STAGE(PG8_SB(0, 1), b2 + hstep, voffB);
            PG8_WAIT_V(6); PG8_BAR; PG8_MMA(1, 1, At, B1); PG8_BAR;
            PG8_LDB(B0, 1, 0); PG8_SCHED; PG8_LDA(At, 1, 0); PG8_STAGE(PG8_SA(0, 1), a2 + hstep, voffA);
            PG8_WAIT_L(8); PG8_BAR; PG8_WAIT_L(0); PG8_MMA(0, 0, At, B0); PG8_BAR; PG8_SCHED;
            PG8_LDB(B1, 1, 1); PG8_STAGE(PG8_SB(1, 0), b3, voffB);
            PG8_BAR; PG8_WAIT_L(0); PG8_MMA(0, 1, At, B1); PG8_BAR;
            PG8_LDA(At, 1, 1); PG8_STAGE(PG8_SA(1, 0), a3, voffA);
            PG8_BAR; PG8_WAIT_L(0); PG8_MMA(1, 0, At, B0); PG8_BAR; PG8_SCHED;
            PG8_STAGE(PG8_SB(1, 1), b3 + hstep, voffB);
            PG8_WAIT_V(6); PG8_BAR; PG8_MMA(1, 1, At, B1); PG8_BAR;
        }
        PG8_STAMP();
        if constexpr (!Epi::AFTER_DRAIN) { E(acc, cur, wr, wc, fr, fq); S.done(cur); }
        PG8_STAMP();
        if (!has_next) break;
#pragma unroll
        for (int a = 0; a < 2; ++a)
#pragma unroll
            for (int b = 0; b < 2; ++b)
#pragma unroll
                for (int m = 0; m < 4; ++m)
#pragma unroll
                    for (int n = 0; n < 2; ++n) acc[a][b][m][n] = (f32x4){0.f, 0.f, 0.f, 0.f};
        cur = nxt; cA = nA; cB = nB; ++ui;
    }
    PG8_WAIT_V(0);
    if (wr == 0) PG8_BAR;
    PG8_BAR;
    if constexpr (Epi::AFTER_DRAIN) { E.fused(acc, cur, wr, wc, fr, fq, lds, wid, lane); S.done(cur); }
    PG8_STAMP();
    if (STAMP && wid == 0) { stamps[lane] = lane < nts ? (((unsigned long long)(unsigned)ts_hi << 32) | (unsigned)ts_lo) : 0ull;
        if (lane == 62) stamps[62] = rt_entry; if (lane == 63) stamps[63] = (unsigned long long)wall_clock64(); }
#undef PG8_STAMP
#undef PG8_SA
#undef PG8_SB
#undef PG8_STAGE
#undef PG8_LDA
#undef PG8_LDB
#undef PG8_MMA
#undef PG8_WAIT_V
#undef PG8_WAIT_L
#undef PG8_BAR
#undef PG8_SCHED
}
}

#include <hip/hip_cooperative_groups.h>
#include <cstdio>
namespace cg = cooperative_groups;
#define LAS __attribute__((address_space(3)))
typedef float f4 __attribute__((ext_vector_type(4)));
typedef float f2 __attribute__((ext_vector_type(2)));
typedef unsigned u4 __attribute__((ext_vector_type(4)));
typedef unsigned u2 __attribute__((ext_vector_type(2)));
typedef unsigned short u16;

constexpr int D = 2048, FF = 5632, MROWS = 12288, MCTX = 4096;
constexpr int NHY = 3072, NGD = 4352, NWIN = 7200, NWINP = 7424;
constexpr int NT = 512;
constexpr int LDS_BYTES = 163840;
constexpr int NITEM_PREP = 1536;
constexpr float RMS_EPS = 1e-6f;

constexpr size_t al256(size_t x) { return (x + 255) & ~(size_t)255; }
constexpr size_t WS_WIN = 0;
constexpr size_t WS_WOUT = WS_WIN + (size_t)NWINP * D * 2;
constexpr size_t WS_FFGU = WS_WOUT + (size_t)D * D * 2;
constexpr size_t WS_FFD = WS_FFGU + (size_t)2 * FF * D * 2;
constexpr size_t WS_FFEND = WS_FFD + (size_t)D * FF * 2;
constexpr size_t WS_H = WS_FFEND;
constexpr size_t WS_MOD = WS_H + (size_t)MROWS * D * 2;
constexpr size_t WS_CTL = WS_MOD + al256((size_t)5 * 18432 * 4);
constexpr size_t WS_H2TAB = WS_CTL + 256;
constexpr size_t WS_HSC = WS_H2TAB + (size_t)2304 * 64 * 4;
constexpr size_t WS_HSL = WS_HSC + (size_t)2 * 1024 * 512 * 8;
constexpr size_t WS_D = WS_HSL + (size_t)2 * 1024 * 4096 * 8;
constexpr size_t WS_ACT = WS_D;
constexpr size_t WS_Y = WS_D + (size_t)MROWS * FF * 2;
constexpr size_t WS_PT = WS_D;
constexpr size_t WS_PG = WS_PT + (size_t)NHY * MROWS * 2;
constexpr size_t WS_QN = WS_PG + (size_t)MROWS * NGD * 2;
constexpr size_t WS_KN = WS_QN + (size_t)MROWS * 1024 * 2;
constexpr size_t WS_W = WS_KN + (size_t)MROWS * 1024 * 2;
constexpr size_t WS_U = WS_W + (size_t)2 * MROWS * 1024 * 2;
constexpr size_t WS_END = WS_U + (size_t)2 * MROWS * 1024 * 2;
constexpr size_t WS_OF = WS_PG;
constexpr size_t WS_OB = WS_OF + (size_t)MROWS * 1024 * 2;
constexpr size_t WS_ZHT = WS_OB + (size_t)MROWS * 1024 * 2;
static_assert(WS_ZHT + (size_t)1024 * MROWS * 4 <= WS_QN, "P7 outputs must fit the PG region");
static_assert(WS_Y + (size_t)MROWS * D * 4 <= WS_END, "Y fits");
constexpr size_t WS_SZ = WS_FFGU;
constexpr size_t WS_ATT = WS_SZ + (size_t)MROWS * 1024 * 2;
constexpr size_t WS_GC = WS_ATT + (size_t)2 * NITEM_PREP * 4096 * 2;
static_assert(WS_GC + (size_t)2 * NITEM_PREP * 64 * 4 <= WS_FFEND, "P6 extras fit the FFN weight region");

struct Args { const float* in[27]; float* out; unsigned char* ws; int ph_lo, ph_hi; };

struct Frame {
    const float *x_prompt, *x_sample, *state, *cvec, *cctx, *ada_w, *ada_b, *npre, *npost, *wg, *wu, *wd, *w_in, *w_out;
    const float *hy_conv, *hw1, *hb1, *hw2, *hb2, *hw3, *hdecay, *hbias, *hnorm, *g_conv, *g_alog, *g_dtb, *g_onorm;
    float* out; unsigned char* ws;
    LAS unsigned char* lds;
    int tid, lane, wave, G;
};

__device__ __forceinline__ u16 f2bf(float f) { unsigned u = __float_as_uint(f); u += 0x7FFFu + ((u >> 16) & 1u); return (u16)(u >> 16); }
__device__ __forceinline__ float bf2f(unsigned b) { return __uint_as_float(b << 16); }
__device__ __forceinline__ unsigned pack2(float a, float b) { return (unsigned)f2bf(a) | ((unsigned)f2bf(b) << 16); }
__device__ __forceinline__ float bflo(unsigned w) { return __uint_as_float(w << 16); }
__device__ __forceinline__ float bfhi(unsigned w) { return __uint_as_float(w & 0xffff0000u); }
__device__ __forceinline__ float wave_sum(float v) {
#pragma unroll
    for (int o = 32; o >= 1; o >>= 1) v += __shfl_xor(v, o);
    return v; }
__device__ __forceinline__ float silu_f(float x) { return x / (1.0f + __expf(-x)); }
__device__ __forceinline__ int modidx(int r) { return r < MCTX ? 0 : 1 + ((r - MCTX) >> 11); }

template <int MAP>
__device__ __forceinline__ void conv_tile(const Frame& F, const float* src, int N, u16* dst, int ldd, int kt, int nt) {
    LAS float* T = (LAS float*)F.lds;
    int tid = F.tid; asm volatile("" : "+v"(tid)); const int k0 = kt * 64, n0 = nt * 64;
#pragma unroll
    for (int p = 0; p < 2; ++p) { const int kr = (tid >> 4) + 32 * p, c4 = tid & 15, n = n0 + 4 * c4;
        f4 v = (f4){0.f, 0.f, 0.f, 0.f}; if (n < N) v = *(const f4*)(src + (size_t)(k0 + kr) * N + n);
        T[(4 * c4 + 0) * 65 + kr] = v[0]; T[(4 * c4 + 1) * 65 + kr] = v[1]; T[(4 * c4 + 2) * 65 + kr] = v[2]; T[(4 * c4 + 3) * 65 + kr] = v[3]; }
    __syncthreads();
    { const int n = tid >> 3, seg = tid & 7, nn = n0 + n;
      if (nn < N) { const int row = MAP == 0 ? nn : ((nn >> 7) * 256 + (MAP - 1) * 128 + (nn & 127));
          u4 w; w.x = pack2(T[n * 65 + 8 * seg + 0], T[n * 65 + 8 * seg + 1]); w.y = pack2(T[n * 65 + 8 * seg + 2], T[n * 65 + 8 * seg + 3]);
          w.z = pack2(T[n * 65 + 8 * seg + 4], T[n * 65 + 8 * seg + 5]); w.w = pack2(T[n * 65 + 8 * seg + 6], T[n * 65 + 8 * seg + 7]);
          *(u4*)(dst + (size_t)row * ldd + k0 + 8 * seg) = w; } }
    __syncthreads();
}
__device__ void conv_ffn(const Frame& F, int f) {
    const float* wg = F.wg + (size_t)f * D * FF; const float* wu = F.wu + (size_t)f * D * FF; const float* wd = F.wd + (size_t)f * FF * D;
    u16* gu = (u16*)(F.ws + WS_FFGU); u16* dd = (u16*)(F.ws + WS_FFD);
    for (int t = blockIdx.x; t < 3 * 2816; t += F.G) {
        if (t < 2816) conv_tile<1>(F, wg, FF, gu, D, t / 88, t % 88);
        else if (t < 5632) { const int u = t - 2816; conv_tile<2>(F, wu, FF, gu, D, u / 88, u % 88); }
        else { const int u = t - 5632; conv_tile<0>(F, wd, D, dd, FF, u / 32, u % 32); }
    }
}
__device__ void conv_inout(const Frame& F) {
    u16* win = (u16*)(F.ws + WS_WIN); u16* wout = (u16*)(F.ws + WS_WOUT);
    for (int t = blockIdx.x; t < 32 * 113 + 1024; t += F.G) {
        if (t < 32 * 113) conv_tile<0>(F, F.w_in, NWIN, win, D, t / 113, t % 113);
        else { const int u = t - 32 * 113; conv_tile<0>(F, F.w_out, D, wout, D, u / 32, u % 32); }
    }
    for (size_t i = (size_t)blockIdx.x * NT + F.tid; i < (size_t)(NWINP - NWIN) * D / 8; i += (size_t)F.G * NT) *(u4*)(win + (size_t)NWIN * D + i * 8) = (u4){0u, 0u, 0u, 0u};
}
__device__ void mod_gemv(const Frame& F) {
    LAS float* sv = (LAS float*)F.lds;
    LAS float* red = sv + 5 * 2048;
    const int tid = F.tid;
    for (int i = tid; i < 5 * 2048; i += NT) { const int v = i >> 11, k = i & 2047; const float c = v == 0 ? F.cctx[k] : F.cvec[(v - 1) * 2048 + k]; sv[i] = silu_f(c); }
    __syncthreads();
    float* mod = (float*)(F.ws + WS_MOD);
    for (int chunk = blockIdx.x; chunk < 256; chunk += F.G) {
        const int col0 = chunk * 72;
        if (tid < 504) { const int kg = tid / 18, cq = tid % 18;
            f4 a0 = (f4){0.f, 0.f, 0.f, 0.f}, a1 = a0, a2 = a0, a3 = a0, a4 = a0;
            for (int k = kg; k < 2048; k += 28) { const f4 w = *(const f4*)(F.ada_w + (size_t)k * 18432 + col0 + 4 * cq);
                a0 += sv[k] * w; a1 += sv[2048 + k] * w; a2 += sv[4096 + k] * w; a3 += sv[6144 + k] * w; a4 += sv[8192 + k] * w; }
            LAS float* rp = red + (kg * 18 + cq) * 20;
            *(LAS f4*)(rp + 0) = a0; *(LAS f4*)(rp + 4) = a1; *(LAS f4*)(rp + 8) = a2; *(LAS f4*)(rp + 12) = a3; *(LAS f4*)(rp + 16) = a4; }
        __syncthreads();
        if (tid < 360) { const int v = tid / 72, c = tid % 72, cq = c >> 2, j = c & 3; float s = 0.f;
            for (int kg = 0; kg < 28; ++kg) s += red[(kg * 18 + cq) * 20 + v * 4 + j];
            mod[v * 18432 + col0 + c] = s + F.ada_b[col0 + c]; }
        __syncthreads();
    }
}
__device__ void filt_h2(const Frame& F) {
    float* tab = (float*)(F.ws + WS_H2TAB);
    for (int p = blockIdx.x * 8 + F.wave; p < 2304; p += F.G * 8) {
        int lane = F.lane; asm volatile("" : "+v"(lane));
        const int L = p < 256 ? 256 : 2048, idx = p < 256 ? p : p - 256;
        const float t = (float)idx / (float)(L - 1), invL = 1.0f / (float)L;
        float a = F.hb1[lane] + t * F.hw1[lane];
#pragma unroll
        for (int b = 1; b <= 16; ++b) { const int m = (idx * b) & (L - 1); const float rev = (float)m * invL;
            a += __builtin_amdgcn_cosf(rev) * F.hw1[b * 64 + lane] + __builtin_amdgcn_sinf(rev) * F.hw1[(16 + b) * 64 + lane]; }
        const float h1 = __sinf(a);
        float a2 = F.hb2[lane];
#pragma unroll 4
        for (int i = 0; i < 64; ++i) a2 += __shfl(h1, i) * F.hw2[i * 64 + lane];
        tab[p * 64 + lane] = __sinf(a2);
    }
}

__device__ __forceinline__ void fft_fwd(LAS f2* Z, int Nf, int tid) {
    for (int h = Nf >> 1; h >= 1; h >>= 1) {
        __syncthreads();
        const float inv2h = 0.5f / (float)h;
#pragma unroll
        for (int q = 0; q < 4; ++q) { const int b = tid + NT * q, j = b & (h - 1), i0 = ((b - j) << 1) + j, i1 = i0 + h;
            const float rev = (float)j * inv2h, c = __builtin_amdgcn_cosf(rev), s = __builtin_amdgcn_sinf(rev);
            const f2 a = Z[i0], bb = Z[i1]; Z[i0] = a + bb; const f2 d = a - bb; Z[i1] = (f2){d.x * c + d.y * s, d.y * c - d.x * s}; }
    }
    __syncthreads();
}
__device__ __forceinline__ void fft_inv(LAS f2* Z, int Nf, int tid) {
    for (int h = 1; h < Nf; h <<= 1) {
        __syncthreads();
        const float inv2h = 0.5f / (float)h;
#pragma unroll
        for (int q = 0; q < 4; ++q) { const int b = tid + NT * q, j = b & (h - 1), i0 = ((b - j) << 1) + j, i1 = i0 + h;
            const float rev = (float)j * inv2h, c = __builtin_amdgcn_cosf(rev), s = __builtin_amdgcn_sinf(rev);
            const f2 a = Z[i0], bb = Z[i1]; const f2 t = (f2){bb.x * c - bb.y * s, bb.x * s + bb.y * c}; Z[i0] = a + t; Z[i1] = a - t; }
    }
    __syncthreads();
}
__device__ void filt_item(const Frame& F, int it) {
    LAS f2* Z = (LAS f2*)F.lds;
    LAS float* w3s = (LAS float*)(F.lds + 32768);
    LAS float* wsum = w3s + 1024;
    int tid = F.tid; asm volatile("" : "+v"(tid));
    const bool lat = it < 2048;
    const int L = lat ? 2048 : 256, Nf = 2 * L, o = lat ? (it >> 10) : ((it - 2048) >> 7), c0 = lat ? (it & 1023) : (((it - 2048) & 127) * 8), nP = lat ? 1 : 8;
    const float* tab = (const float*)(F.ws + WS_H2TAB) + (size_t)(lat ? 256 : 0) * 64;
    __syncthreads();
    for (int i = tid; i < nP * 128; i += NT) { const int p = i >> 7, dr = (i >> 6) & 1, j = i & 63; w3s[i] = F.hw3[(size_t)j * 4096 + dr * 2048 + o * 1024 + c0 + p]; }
    __syncthreads();
    const int e0 = tid * 8, p = e0 / Nf, n0 = e0 % Nf, c = c0 + p;
    const float dec = fabsf(F.hdecay[o * 1024 + c]), invLm1 = 1.0f / (float)(L - 1);
    float val[8]; float sa = 0.f;
#pragma unroll
    for (int q = 0; q < 8; ++q) { const int n = n0 + q; float v = 0.f;
        if (n != L) { const int pos = n < L ? n : Nf - n, dr = n < L ? 0 : 1; const float* hr = tab + (size_t)pos * 64; LAS const float* wc = w3s + p * 128 + dr * 64; float dot = 0.f;
#pragma unroll
            for (int j4 = 0; j4 < 16; ++j4) { const f4 hv = *(const f4*)(hr + 4 * j4); const f4 wv = *(LAS const f4*)(wc + 4 * j4); dot += hv[0] * wv[0] + hv[1] * wv[1] + hv[2] * wv[2] + hv[3] * wv[3]; }
            v = dot * (__expf(-(float)pos * invLm1 * dec) + 0.05f); }
        val[q] = v; sa += fabsf(v); }
    sa = wave_sum(sa);
    if (F.lane == 0) wsum[F.wave] = sa;
    __syncthreads();
    float tot = wsum[F.wave];
    if (lat) { tot = 0.f;
#pragma unroll
        for (int w = 0; w < 8; ++w) tot += wsum[w]; }
    const float sc = 1.0f / (tot * (float)Nf);
#pragma unroll
    for (int q = 0; q < 8; ++q) Z[e0 + q] = (f2){val[q] * sc, 0.f};
    fft_fwd(Z, Nf, tid);
    f2* dst = lat ? (f2*)(F.ws + WS_HSL) + (size_t)(o * 1024 + c) * 4096 + n0 : (f2*)(F.ws + WS_HSC) + (size_t)(o * 1024 + c) * 512 + n0;
#pragma unroll
    for (int q = 0; q < 8; q += 2) { const f2 a = Z[e0 + q], b = Z[e0 + q + 1]; *(f4*)(dst + q) = (f4){a.x, a.y, b.x, b.y}; }
}

__device__ __forceinline__ void load_x0(const Frame& F, int r, int lane, f4 (&x)[8]) {
    if (r < MCTX) { const f4* p = (const f4*)(F.x_prompt + (size_t)r * D);
#pragma unroll
        for (int i = 0; i < 8; ++i) x[i] = p[i * 64 + lane]; }
    else { const int rr = r - MCTX; const f4* p = (const f4*)(F.x_sample + (size_t)rr * D); const int t = rr & 2047; const float gr = (float)(t >> 6), gc = (float)(t & 63);
#pragma unroll
        for (int i = 0; i < 8; ++i) { f4 v = p[i * 64 + lane]; const int col = (i * 64 + lane) * 4, ii = col & 511; const float pos = (i < 4) ? gr : gc;
#pragma unroll
            for (int j = 0; j < 4; ++j) { const float om = __builtin_amdgcn_exp2f(-(float)(ii + j) * (13.287712379549449f / 512.0f)); const float a = pos * om * 0.15915494309189535f;
                v[j] += ((i >> 1) & 1) ? __builtin_amdgcn_cosf(a) : __builtin_amdgcn_sinf(a); }
            x[i] = v; } }
}
__device__ __forceinline__ void adaln_store(const Frame& F, int r, int lane, const f4 (&x)[8], int pre_i, int shift_i, int scale_i) {
    float ss = 0.f;
#pragma unroll
    for (int i = 0; i < 8; ++i) ss += x[i][0] * x[i][0] + x[i][1] * x[i][1] + x[i][2] * x[i][2] + x[i][3] * x[i][3];
    ss = wave_sum(ss);
    const float rs = rsqrtf(ss * (1.0f / D) + RMS_EPS);
    const float* md = (const float*)(F.ws + WS_MOD) + (size_t)modidx(r) * 18432;
    u16* H = (u16*)(F.ws + WS_H) + (size_t)r * D;
#pragma unroll
    for (int i = 0; i < 8; ++i) { const int col = (i * 64 + lane) * 4;
        const f4 g = *(const f4*)(F.npre + pre_i * D + col), sh = *(const f4*)(md + shift_i * D + col), sc = *(const f4*)(md + scale_i * D + col);
        const f4 hv = x[i] * rs * g * (1.0f + sc) + sh;
        u2 w; w.x = pack2(hv[0], hv[1]); w.y = pack2(hv[2], hv[3]); *(u2*)(H + col) = w; }
}
__device__ void phase_adaln1(const Frame& F) {
    for (int r = blockIdx.x * 8 + F.wave; r < MROWS; r += F.G * 8) { f4 x[8]; load_x0(F, r, F.lane, x); adaln_store(F, r, F.lane, x, 0, 0, 1); }
}
__device__ void phase_res(const Frame& F, int which) {
    const float* Y = (const float*)(F.ws + WS_Y);
    const int gate_i = which == 0 ? 2 : (which == 1 ? 5 : 8); const float gsc = which == 1 ? 1.0f : 0.5f;
    for (int r = blockIdx.x * 8 + F.wave; r < MROWS; r += F.G * 8) {
        const int lane = F.lane; f4 x[8];
        float* X = F.out + (size_t)r * D;
        if (which == 0) load_x0(F, r, lane, x);
        else {
#pragma unroll
            for (int i = 0; i < 8; ++i) x[i] = *(const f4*)(X + (i * 64 + lane) * 4); }
        f4 y[8]; float ss = 0.f;
#pragma unroll
        for (int i = 0; i < 8; ++i) { y[i] = *(const f4*)(Y + (size_t)r * D + (i * 64 + lane) * 4); ss += y[i][0] * y[i][0] + y[i][1] * y[i][1] + y[i][2] * y[i][2] + y[i][3] * y[i][3]; }
        ss = wave_sum(ss);
        const float rs = rsqrtf(ss * (1.0f / D) + RMS_EPS) * gsc;
        const float* md = (const float*)(F.ws + WS_MOD) + (size_t)modidx(r) * 18432;
#pragma unroll
        for (int i = 0; i < 8; ++i) { const int col = (i * 64 + lane) * 4;
            const f4 g = *(const f4*)(F.npost + which * D + col), gt = *(const f4*)(md + gate_i * D + col);
            x[i] += gt * (y[i] * rs * g);
            *(f4*)(X + col) = x[i]; }
        if (which == 0) adaln_store(F, r, lane, x, 1, 3, 4);
        else if (which == 1) adaln_store(F, r, lane, x, 2, 6, 7);
    }
}

__device__ __forceinline__ void gdn_conv_load(const u16* PG, const float* cw, int r0, int seq_start, int seq_end, int colbase, LAS float* dst, int tid) {
    const int c4 = tid & 31, tr = tid >> 5, col = colbase + 4 * c4;
    const f4 w0 = *(const f4*)(cw + col), w1 = *(const f4*)(cw + 3072 + col), w2 = *(const f4*)(cw + 6144 + col);
#pragma unroll
    for (int p = 0; p < 4; ++p) { const int i = tr + 16 * p, r = r0 + i;
        const u16* pr = PG + (size_t)r * NGD + col;
        const u2 m = *(const u2*)pr; u2 l = (u2){0u, 0u}, rt = (u2){0u, 0u};
        if (r > seq_start) l = *(const u2*)(pr - NGD);
        if (r + 1 < seq_end) rt = *(const u2*)(pr + NGD);
        f4 v;
        v[0] = w0[0] * bflo(l.x) + w1[0] * bflo(m.x) + w2[0] * bflo(rt.x); v[1] = w0[1] * bfhi(l.x) + w1[1] * bfhi(m.x) + w2[1] * bfhi(rt.x);
        v[2] = w0[2] * bflo(l.y) + w1[2] * bflo(m.y) + w2[2] * bflo(rt.y); v[3] = w0[3] * bfhi(l.y) + w1[3] * bfhi(m.y) + w2[3] * bfhi(rt.y);
        v[0] = silu_f(v[0]); v[1] = silu_f(v[1]); v[2] = silu_f(v[2]); v[3] = silu_f(v[3]);
        *(LAS f4*)(dst + i * 132 + 4 * c4) = v; }
}

template <int I> struct FwdSub {
    static __device__ __forceinline__ void run(float (&x)[64], LAS const float* Ad, LAS const float* bt, LAS const float* gc, LAS const float* src, int rstep, float wsel) {
        FwdSub<I - 1>::run(x, Ad, bt, gc, src, rstep, wsel);
        const float eg = __expf(gc[I] * wsel);
        float s = bt[I] * eg * src[I * rstep];
#pragma unroll
        for (int j4 = 0; j4 < (I + 3) / 4; ++j4) { const f4 a = *(LAS const f4*)(Ad + I * 64 + 4 * j4);
            if (4 * j4 + 0 < I) s -= a[0] * x[4 * j4 + 0]; if (4 * j4 + 1 < I) s -= a[1] * x[4 * j4 + 1]; if (4 * j4 + 2 < I) s -= a[2] * x[4 * j4 + 2]; if (4 * j4 + 3 < I) s -= a[3] * x[4 * j4 + 3]; }
        x[I] = s;
        asm volatile("" ::: "memory");
    }
};
template <> struct FwdSub<-1> { static __device__ __forceinline__ void run(float (&)[64], LAS const float*, LAS const float*, LAS const float*, LAS const float*, int, float) {} };
__device__ void gdn_prep_item(const Frame& F, int item) {
    int tid = F.tid; asm volatile("" : "+v"(tid));
    const int cb = item >> 3, h = item & 7, r0 = cb * 64;
    int seq_start, seq_end;
    if (r0 < MCTX) { seq_start = r0 & ~255; seq_end = seq_start + 256; } else { seq_start = MCTX + ((r0 - MCTX) & ~2047); seq_end = seq_start + 2048; }
    LAS float* Kt = (LAS float*)F.lds; LAS float* Qt = Kt + 64 * 132; LAS float* G = Qt + 64 * 132; LAS float* P = G + 64 * 65; LAS float* A = P + 64 * 65;
    LAS float* gcs = A + 8192; LAS float* bts = gcs + 128;
    const u16* PG = (const u16*)(F.ws + WS_PG);
    __syncthreads();
    gdn_conv_load(PG, F.g_conv, r0, seq_start, seq_end, h * 128, Qt, tid);
    gdn_conv_load(PG, F.g_conv, r0, seq_start, seq_end, 1024 + h * 128, Kt, tid);
    { const int i = tid >> 3, seg = tid & 7; const u16* zp = PG + (size_t)(r0 + i) * NGD + 3072 + h * 128 + seg * 16; u16* sp = (u16*)(F.ws + WS_SZ) + (size_t)(r0 + i) * 1024 + h * 128 + seg * 16;
#pragma unroll
      for (int q = 0; q < 2; ++q) { const u4 z = *(const u4*)(zp + 8 * q); u4 w;
          w.x = pack2(silu_f(bflo(z.x)), silu_f(bfhi(z.x))); w.y = pack2(silu_f(bflo(z.y)), silu_f(bfhi(z.y))); w.z = pack2(silu_f(bflo(z.z)), silu_f(bfhi(z.z))); w.w = pack2(silu_f(bflo(z.w)), silu_f(bfhi(z.w)));
          *(u4*)(sp + 8 * q) = w; } }
    if (tid < 128) { const int d = tid >> 6, i = tid & 63, r = d ? r0 + 63 - i : r0 + i;
        const u16* abp = PG + (size_t)r * NGD + 4096 + d * 16;
        const float ad = bf2f(abp[h]) + F.g_dtb[d * 8 + h], ab = bf2f(abp[8 + h]);
        const float sp = ad > 20.f ? ad : log1pf(__expf(ad));
        const float g = -__expf(F.g_alog[d * 8 + h]) * sp, beta = 1.0f / (1.0f + __expf(-ab));
        float cs = g;
#pragma unroll
        for (int o = 1; o < 64; o <<= 1) { const float t = __shfl_up(cs, o); if (i >= o) cs += t; }
        gcs[d * 64 + i] = cs; bts[d * 64 + i] = beta;
        ((float*)(F.ws + WS_GC))[(size_t)(d * NITEM_PREP + item) * 64 + i] = cs; }
    __syncthreads();
    { const int row2 = tid >> 2, sub = tid & 3; LAS float* rp = (row2 < 64 ? Qt + row2 * 132 : Kt + (row2 - 64) * 132) + sub * 32; float ss = 0.f;
#pragma unroll
      for (int j = 0; j < 8; ++j) { const f4 v = *(LAS f4*)(rp + 4 * j); ss += v[0] * v[0] + v[1] * v[1] + v[2] * v[2] + v[3] * v[3]; }
      ss += __shfl_xor(ss, 1); ss += __shfl_xor(ss, 2);
      const float sc = rsqrtf(ss + RMS_EPS) * (row2 < 64 ? 0.08838834764831845f : 1.0f);
#pragma unroll
      for (int j = 0; j < 8; ++j) { f4 v = *(LAS f4*)(rp + 4 * j); v *= sc; *(LAS f4*)(rp + 4 * j) = v; } }
    __syncthreads();
    { const int i = tid >> 3, seg = tid & 7; u16* qn = (u16*)(F.ws + WS_QN) + (size_t)(r0 + i) * 1024 + h * 128 + seg * 16; u16* kn = (u16*)(F.ws + WS_KN) + (size_t)(r0 + i) * 1024 + h * 128 + seg * 16;
#pragma unroll
      for (int q = 0; q < 2; ++q) { const f4 a = *(LAS f4*)(Qt + i * 132 + seg * 16 + 8 * q), b = *(LAS f4*)(Qt + i * 132 + seg * 16 + 8 * q + 4);
          *(u4*)(qn + 8 * q) = (u4){pack2(a[0], a[1]), pack2(a[2], a[3]), pack2(b[0], b[1]), pack2(b[2], b[3])};
          const f4 c = *(LAS f4*)(Kt + i * 132 + seg * 16 + 8 * q), d = *(LAS f4*)(Kt + i * 132 + seg * 16 + 8 * q + 4);
          *(u4*)(kn + 8 * q) = (u4){pack2(c[0], c[1]), pack2(c[2], c[3]), pack2(d[0], d[1]), pack2(d[2], d[3])}; } }
    { const int i2 = tid >> 4, j4 = tid & 15; float aG[2][4], aP[2][4];
#pragma unroll
      for (int a = 0; a < 2; ++a)
#pragma unroll
          for (int b = 0; b < 4; ++b) { aG[a][b] = 0.f; aP[a][b] = 0.f; }
      for (int d4 = 0; d4 < 32; ++d4) { f4 ki[2], qi[2], kj[4];
#pragma unroll
          for (int a = 0; a < 2; ++a) { ki[a] = *(LAS f4*)(Kt + (i2 + 32 * a) * 132 + 4 * d4); qi[a] = *(LAS f4*)(Qt + (i2 + 32 * a) * 132 + 4 * d4); }
#pragma unroll
          for (int b = 0; b < 4; ++b) kj[b] = *(LAS f4*)(Kt + (j4 + 16 * b) * 132 + 4 * d4);
#pragma unroll
          for (int a = 0; a < 2; ++a)
#pragma unroll
              for (int b = 0; b < 4; ++b) { aG[a][b] += ki[a][0] * kj[b][0] + ki[a][1] * kj[b][1] + ki[a][2] * kj[b][2] + ki[a][3] * kj[b][3];
                  aP[a][b] += qi[a][0] * kj[b][0] + qi[a][1] * kj[b][1] + qi[a][2] * kj[b][2] + qi[a][3] * kj[b][3]; } }
#pragma unroll
      for (int a = 0; a < 2; ++a)
#pragma unroll
          for (int b = 0; b < 4; ++b) { G[(i2 + 32 * a) * 65 + j4 + 16 * b] = aG[a][b]; P[(i2 + 32 * a) * 65 + j4 + 16 * b] = aP[a][b]; } }
    __syncthreads();
    gdn_conv_load(PG, F.g_conv, r0, seq_start, seq_end, 2048 + h * 128, Qt, tid);
    { u16* att = (u16*)(F.ws + WS_ATT);
      for (int e = tid; e < 8192; e += NT) { const int d = e >> 12, i = (e >> 6) & 63, j = e & 63, ri = d ? 63 - i : i, rj = d ? 63 - j : j;
          float a = 0.f, at = 0.f;
          if (i >= j) { const float dec = __expf(gcs[d * 64 + i] - gcs[d * 64 + j]); at = P[ri * 65 + rj] * dec; if (i > j) a = bts[d * 64 + i] * G[ri * 65 + rj] * dec; }
          A[e] = a; att[(size_t)(d * NITEM_PREP + item) * 4096 + (e & 4095)] = f2bf(at); } }
    __syncthreads();
    { const int d = tid >> 8, col = tid & 255; LAS const float* Ad = A + d * 4096; LAS const float* Vt = Qt;
      float x[64];
      LAS const float* src = ((col < 128) ? Vt : Kt) + (col & 127) + (d ? 63 * 132 : 0);
      FwdSub<63>::run(x, Ad, bts + d * 64, gcs + d * 64, src, d ? -132 : 132, (col < 128) ? 0.f : 1.f);
      u16* dst = (u16*)(F.ws + (col < 128 ? WS_U : WS_W)) + (size_t)(d * NITEM_PREP + item) * 8192 + (col & 127);
#pragma unroll
      for (int i = 0; i < 64; ++i) dst[i * 128] = f2bf(x[i]); }
}

__device__ void gdn_scan_item(const Frame& F, int sitem) {
    int tid = F.tid; asm volatile("" : "+v"(tid));
    const int q4 = sitem & 3; int c, s;
    if (sitem < 256) { c = sitem >> 2; s = 16 + (c >> 4); } else { c = (sitem - 256) >> 2; s = c >> 4; }
    const int h = (c >> 1) & 7, d = c & 1;
    const int L = s < 16 ? 256 : 2048, rowbase = s < 16 ? s * 256 : MCTX + (s - 16) * 2048, nc = L >> 6, cb0 = rowbase >> 6;
    LAS float* Wt = (LAS float*)F.lds; LAS float* Qt = Wt + 64 * 132; LAS float* Kt = Qt + 64 * 132; LAS float* At = Kt + 64 * 132;
    LAS float* VN = At + 64 * 68; LAS float* VS = VN + 2048; LAS float* S = VS + 2048; LAS float* gcs = S + 4096;
    const u16* Wg = (const u16*)(F.ws + WS_W); const u16* Ug = (const u16*)(F.ws + WS_U); const u16* QN = (const u16*)(F.ws + WS_QN); const u16* KN = (const u16*)(F.ws + WS_KN);
    const u16* ATT = (const u16*)(F.ws + WS_ATT); const float* GC = (const float*)(F.ws + WS_GC);
    u16* OX = (u16*)(F.ws + (d ? WS_OB : WS_OF));
    __syncthreads();
    { const int k = tid >> 2, v = (tid & 3) * 8;
      f4 a = (f4){0.f, 0.f, 0.f, 0.f}, b = a;
      if (s >= 16) { const float* sp = F.state + ((size_t)((s - 16) * 2 + d) * 8 + h) * 16384 + k * 128 + 32 * q4 + v; a = *(const f4*)sp; b = *(const f4*)(sp + 4); }
      *(LAS f4*)(S + k * 32 + v) = a; *(LAS f4*)(S + k * 32 + v + 4) = b; }
    for (int n = 0; n < nc; ++n) {
        const int cb = d ? cb0 + nc - 1 - n : cb0 + n, it = cb * 8 + h, r0 = cb * 64;
        __syncthreads();
#pragma unroll
        for (int p = 0; p < 2; ++p) { const int e = tid + NT * p, row = e >> 4, seg = e & 15; const int trow = d ? r0 + 63 - row : r0 + row;
            const u4 w = *(const u4*)(Wg + (size_t)(d * NITEM_PREP + it) * 8192 + row * 128 + seg * 8);
            *(LAS f4*)(Wt + row * 132 + seg * 8) = (f4){bflo(w.x), bfhi(w.x), bflo(w.y), bfhi(w.y)}; *(LAS f4*)(Wt + row * 132 + seg * 8 + 4) = (f4){bflo(w.z), bfhi(w.z), bflo(w.w), bfhi(w.w)};
            const u4 q = *(const u4*)(QN + (size_t)trow * 1024 + h * 128 + seg * 8);
            *(LAS f4*)(Qt + row * 132 + seg * 8) = (f4){bflo(q.x), bfhi(q.x), bflo(q.y), bfhi(q.y)}; *(LAS f4*)(Qt + row * 132 + seg * 8 + 4) = (f4){bflo(q.z), bfhi(q.z), bflo(q.w), bfhi(q.w)};
            const u4 k = *(const u4*)(KN + (size_t)trow * 1024 + h * 128 + seg * 8);
            *(LAS f4*)(Kt + row * 132 + seg * 8) = (f4){bflo(k.x), bfhi(k.x), bflo(k.y), bfhi(k.y)}; *(LAS f4*)(Kt + row * 132 + seg * 8 + 4) = (f4){bflo(k.z), bfhi(k.z), bflo(k.w), bfhi(k.w)}; }
        { const int row = tid >> 3, seg = tid & 7; const u4 a = *(const u4*)(ATT + (size_t)(d * NITEM_PREP + it) * 4096 + row * 64 + seg * 8);
          *(LAS f4*)(At + row * 68 + seg * 8) = (f4){bflo(a.x), bfhi(a.x), bflo(a.y), bfhi(a.y)}; *(LAS f4*)(At + row * 68 + seg * 8 + 4) = (f4){bflo(a.z), bfhi(a.z), bflo(a.w), bfhi(a.w)}; }
        if (tid < 64) gcs[tid] = GC[(size_t)(d * NITEM_PREP + it) * 64 + tid];
        const int i = tid >> 3, vc = tid & 7;
        const u2 uu = *(const u2*)(Ug + (size_t)(d * NITEM_PREP + it) * 8192 + i * 128 + 32 * q4 + 4 * vc);
        __syncthreads();
        f4 accW = (f4){0.f, 0.f, 0.f, 0.f}, accQ = accW;
        for (int k4 = 0; k4 < 32; ++k4) { const f4 w = *(LAS f4*)(Wt + i * 132 + 4 * k4), q = *(LAS f4*)(Qt + i * 132 + 4 * k4);
#pragma unroll
            for (int kk = 0; kk < 4; ++kk) { const f4 sv = *(LAS f4*)(S + (4 * k4 + kk) * 32 + 4 * vc); accW += w[kk] * sv; accQ += q[kk] * sv; } }
        const float gci = gcs[i], glast = gcs[63];
        const f4 vn = (f4){bflo(uu.x), bfhi(uu.x), bflo(uu.y), bfhi(uu.y)} - accW;
        *(LAS f4*)(VN + i * 32 + 4 * vc) = vn; *(LAS f4*)(VS + i * 32 + 4 * vc) = vn * __expf(glast - gci);
        f4 o = accQ * __expf(gci);
        __syncthreads();
        for (int j4 = 0; j4 < 16; ++j4) { const f4 a = *(LAS f4*)(At + i * 68 + 4 * j4);
#pragma unroll
            for (int jj = 0; jj < 4; ++jj) o += a[jj] * *(LAS f4*)(VN + (4 * j4 + jj) * 32 + 4 * vc); }
        { const int trow = d ? r0 + 63 - i : r0 + i; *(u2*)(OX + (size_t)trow * 1024 + h * 128 + 32 * q4 + 4 * vc) = (u2){pack2(o[0], o[1]), pack2(o[2], o[3])}; }
        { const int kk = tid >> 3; const float eg = __expf(glast);
          f4 s0 = *(LAS f4*)(S + kk * 32 + 4 * vc) * eg, s1 = *(LAS f4*)(S + (kk + 64) * 32 + 4 * vc) * eg;
          for (int cc = 0; cc < 64; ++cc) { const f4 v = *(LAS f4*)(VS + cc * 32 + 4 * vc); s0 += Kt[cc * 132 + kk] * v; s1 += Kt[cc * 132 + kk + 64] * v; }
          *(LAS f4*)(S + kk * 32 + 4 * vc) = s0; *(LAS f4*)(S + (kk + 64) * 32 + 4 * vc) = s1; }
    }
    __syncthreads();
    if (s < 16) { const int k = tid >> 2, v = (tid & 3) * 8;
        float* op = F.out + (size_t)MROWS * D + ((size_t)(s * 2 + d) * 8 + h) * 16384 + k * 128 + 32 * q4 + v;
        *(f4*)op = *(LAS f4*)(S + k * 32 + v); *(f4*)(op + 4) = *(LAS f4*)(S + k * 32 + v + 4); }
}

__device__ __forceinline__ void hy_load_conv(const u16* PT, const float* cw, int ch, int tb, int tau, int L, float (&pc)[8]) {
    const u16* p = PT + (size_t)ch * MROWS + tb + tau;
    const u4 m = *(const u4*)p; float v[10];
    v[0] = (tau & (L - 1)) ? bf2f(p[-1]) : 0.f; v[9] = ((tau + 8) & (L - 1)) ? bf2f(p[8]) : 0.f;
    v[1] = bflo(m.x); v[2] = bfhi(m.x); v[3] = bflo(m.y); v[4] = bfhi(m.y); v[5] = bflo(m.z); v[6] = bfhi(m.z); v[7] = bflo(m.w); v[8] = bfhi(m.w);
    const float w0 = cw[ch], w1 = cw[3072 + ch], w2 = cw[6144 + ch];
#pragma unroll
    for (int q = 0; q < 8; ++q) pc[q] = w0 * v[q] + w1 * v[q + 1] + w2 * v[q + 2];
}
__device__ void hyena_item(const Frame& F, int hitem) {
    int tid = F.tid; asm volatile("" : "+v"(tid));
    const bool lat = hitem < 2048;
    const int c = lat ? (hitem >> 1) : (hitem - 2048), tb = lat ? MCTX + (hitem & 1) * 4096 : 0, L = lat ? 2048 : 256, Nf = 2 * L;
    LAS f2* Z = (LAS f2*)F.lds; LAS float* Zf = (LAS float*)F.lds; LAS float* UK = Zf + 8192; LAS float* X1s = UK + 4096; LAS float* X2s = X1s + 4096;
    const u16* PT = (const u16*)(F.ws + WS_PT);
    const int tau = tid * 8, sq = tau / L, t = tau & (L - 1), zi = (sq >> 1) * Nf + t, comp = sq & 1;
    __syncthreads();
#pragma unroll
    for (int q = 0; q < 8; ++q) Z[tid + NT * q] = (f2){0.f, 0.f};
    float u[8], x1[8], x2[8];
    hy_load_conv(PT, F.hy_conv, c, tb, tau, L, u); hy_load_conv(PT, F.hy_conv, 1024 + c, tb, tau, L, x1); hy_load_conv(PT, F.hy_conv, 2048 + c, tb, tau, L, x2);
    __syncthreads();
#pragma unroll
    for (int q = 0; q < 8; ++q) Zf[2 * (zi + q) + comp] = u[q];
#pragma unroll 1
    for (int o = 0; o < 2; ++o) {
        fft_fwd(Z, Nf, tid);
        const f2* Hs = lat ? (const f2*)(F.ws + WS_HSL) + (size_t)(o * 1024 + c) * 4096 : (const f2*)(F.ws + WS_HSC) + (size_t)(o * 1024 + c) * 512;
#pragma unroll
        for (int q = 0; q < 8; ++q) { const int e = tid + NT * q; const f2 hh = Hs[e & (Nf - 1)]; const f2 z = Z[e]; Z[e] = (f2){z.x * hh.x - z.y * hh.y, z.x * hh.y + z.y * hh.x}; }
        fft_inv(Z, Nf, tid);
        const float bias = F.hbias[o * 1024 + c];
        float y[8];
#pragma unroll
        for (int q = 0; q < 8; ++q) y[q] = Zf[2 * (zi + q) + comp] + u[q] * bias;
        if (o == 0) {
#pragma unroll
            for (int q = 0; q < 8; ++q) u[q] = x1[q] * y[q];
            __syncthreads();
#pragma unroll
            for (int q = 0; q < 8; ++q) Z[tid + NT * q] = (f2){0.f, 0.f};
            __syncthreads();
#pragma unroll
            for (int q = 0; q < 8; ++q) Zf[2 * (zi + q) + comp] = u[q];
        } else {
            float* zo = (float*)(F.ws + WS_ZHT) + (size_t)c * MROWS + tb + tau;
            *(f4*)zo = (f4){x2[0] * y[0], x2[1] * y[1], x2[2] * y[2], x2[3] * y[3]}; *(f4*)(zo + 4) = (f4){x2[4] * y[4], x2[5] * y[5], x2[6] * y[6], x2[7] * y[7]};
        }
    }
}

__device__ void hy_out_item(const Frame& F, int tile) {
    int tid = F.tid; asm volatile("" : "+v"(tid)); const int t0 = tile * 32;
    LAS float* T = (LAS float*)F.lds;
    LAS float* red = T + 1024 * 33;
    LAS float* rsv = red + 512;
    const float* ZHT = (const float*)(F.ws + WS_ZHT);
    __syncthreads();
#pragma unroll 4
    for (int p = 0; p < 16; ++p) { const int e = tid + NT * p, c = e >> 3, q = e & 7; const f4 v = *(const f4*)(ZHT + (size_t)c * MROWS + t0 + 4 * q);
        T[c * 33 + 4 * q + 0] = v[0]; T[c * 33 + 4 * q + 1] = v[1]; T[c * 33 + 4 * q + 2] = v[2]; T[c * 33 + 4 * q + 3] = v[3]; }
    __syncthreads();
    { const int t = tid & 31, cg_ = tid >> 5; float s = 0.f;
      for (int k = 0; k < 64; ++k) { const float v = T[(cg_ * 64 + k) * 33 + t]; s += v * v; }
      red[cg_ * 32 + t] = s; }
    __syncthreads();
    if (tid < 32) { float s = 0.f;
#pragma unroll
        for (int g = 0; g < 16; ++g) s += red[g * 32 + tid];
        rsv[tid] = rsqrtf(s * (1.0f / 1024.0f) + RMS_EPS); }
    __syncthreads();
    u16* YM = (u16*)(F.ws + WS_H);
#pragma unroll 2
    for (int p = 0; p < 8; ++p) { const int e = tid + NT * p, t = e >> 7, c8 = e & 127; const float rs = rsv[t]; float v[8];
#pragma unroll
        for (int k = 0; k < 8; ++k) v[k] = T[(8 * c8 + k) * 33 + t] * rs * F.hnorm[8 * c8 + k];
        *(u4*)(YM + (size_t)(t0 + t) * D + 8 * c8) = (u4){pack2(v[0], v[1]), pack2(v[2], v[3]), pack2(v[4], v[5]), pack2(v[6], v[7])}; }
}
__device__ void gdn_out_rows(const Frame& F) {
    const u16* OF = (const u16*)(F.ws + WS_OF); const u16* OB = (const u16*)(F.ws + WS_OB); const u16* SZ = (const u16*)(F.ws + WS_SZ); u16* YM = (u16*)(F.ws + WS_H);
    const int lane = F.lane, col = (lane >> 3) * 128 + (lane & 7) * 16;
    for (int r = blockIdx.x * 8 + F.wave; r < MROWS; r += F.G * 8) {
        float o[16]; float ss = 0.f;
#pragma unroll
        for (int q = 0; q < 2; ++q) { const u4 a = *(const u4*)(OF + (size_t)r * 1024 + col + 8 * q), b = *(const u4*)(OB + (size_t)r * 1024 + col + 8 * q);
            o[8 * q + 0] = bflo(a.x) + bflo(b.x); o[8 * q + 1] = bfhi(a.x) + bfhi(b.x); o[8 * q + 2] = bflo(a.y) + bflo(b.y); o[8 * q + 3] = bfhi(a.y) + bfhi(b.y);
            o[8 * q + 4] = bflo(a.z) + bflo(b.z); o[8 * q + 5] = bfhi(a.z) + bfhi(b.z); o[8 * q + 6] = bflo(a.w) + bflo(b.w); o[8 * q + 7] = bfhi(a.w) + bfhi(b.w); }
#pragma unroll
        for (int k = 0; k < 16; ++k) ss += o[k] * o[k];
        ss += __shfl_xor(ss, 1); ss += __shfl_xor(ss, 2); ss += __shfl_xor(ss, 4);
        const float rs = rsqrtf(ss * (1.0f / 128.0f) + RMS_EPS);
#pragma unroll
        for (int q = 0; q < 2; ++q) { const u4 z = *(const u4*)(SZ + (size_t)r * 1024 + col + 8 * q); const int cc = (lane & 7) * 16 + 8 * q; float v[8];
            const float zz[8] = {bflo(z.x), bfhi(z.x), bflo(z.y), bfhi(z.y), bflo(z.z), bfhi(z.z), bflo(z.w), bfhi(z.w)};
#pragma unroll
            for (int k = 0; k < 8; ++k) v[k] = o[8 * q + k] * rs * F.g_onorm[cc + k] * zz[k];
            *(u4*)(YM + (size_t)r * D + 1024 + col + 8 * q) = (u4){pack2(v[0], v[1]), pack2(v[2], v[3]), pack2(v[4], v[5]), pack2(v[6], v[7])}; }
    }
}

constexpr int N_PHASES = 14;
#ifndef ONE_LAUNCH
#define ONE_LAUNCH 0
#endif
__global__ void __launch_bounds__(NT, 2) fwd_kernel(Args args) {
    extern __shared__ __attribute__((aligned(16))) unsigned char lds_raw[];
    cg::grid_group grid = cg::this_grid();
    Frame F;
    F.x_prompt = args.in[0]; F.x_sample = args.in[1]; F.state = args.in[2]; F.cvec = args.in[3]; F.cctx = args.in[4]; F.ada_w = args.in[5]; F.ada_b = args.in[6]; F.npre = args.in[7]; F.npost = args.in[8];
    F.wg = args.in[9]; F.wu = args.in[10]; F.wd = args.in[11]; F.w_in = args.in[12]; F.w_out = args.in[13]; F.hy_conv = args.in[14]; F.hw1 = args.in[15]; F.hb1 = args.in[16]; F.hw2 = args.in[17]; F.hb2 = args.in[18];
    F.hw3 = args.in[19]; F.hdecay = args.in[20]; F.hbias = args.in[21]; F.hnorm = args.in[22]; F.g_conv = args.in[23]; F.g_alog = args.in[24]; F.g_dtb = args.in[25]; F.g_onorm = args.in[26];
    F.out = args.out; F.ws = args.ws; F.lds = (LAS unsigned char*)lds_raw;
    F.tid = threadIdx.x; F.lane = F.tid & 63; F.wave = __builtin_amdgcn_readfirstlane(F.tid >> 6); F.G = gridDim.x;
    const int lo = args.ph_lo, hi = args.ph_hi;
    unsigned* ctl = (unsigned*)(F.ws + WS_CTL);
    LAS int* qslot = (LAS int*)(F.lds + LDS_BYTES - 16);
    const pg8::bf16_t* Hb = (const pg8::bf16_t*)(F.ws + WS_H);
#define IN(k) (lo <= (k) && (k) < hi)
#define SEAM(k) do { if (IN(k) && IN((k) + 1)) grid.sync(); } while (0)

    if (IN(0)) { if (blockIdx.x == 0 && F.tid == 0) { ctl[0] = 0u; ctl[1] = 0u; }
        mod_gemv(F); filt_h2(F); conv_inout(F); conv_ffn(F, 0); }
    SEAM(0);
    if (IN(1)) { phase_adaln1(F); for (int it = blockIdx.x; it < 2304; it += F.G) filt_item(F, it); }
    SEAM(1);
    if (IN(2)) { pg8::Gemm g{Hb, (const pg8::bf16_t*)(F.ws + WS_FFGU), MROWS, 2 * FF, D}; pg8::StaticOrder S; S.init(MROWS, 2 * FF, F.G, (int)blockIdx.x);
        pg8::EpiSwiglu E{(pg8::bf16_t*)(F.ws + WS_ACT), FF}; pg8::gemm_phase<pg8::EpiSwiglu, pg8::StaticOrder>(F.lds, g, S, E, nullptr); }
    SEAM(2);
    if (IN(3)) { pg8::Gemm g{(const pg8::bf16_t*)(F.ws + WS_ACT), (const pg8::bf16_t*)(F.ws + WS_FFD), MROWS, D, FF}; pg8::StaticOrder S; S.init(MROWS, D, F.G, (int)blockIdx.x);
        pg8::EpiF32 E{(float*)(F.ws + WS_Y), D, nullptr}; pg8::gemm_phase<pg8::EpiF32, pg8::StaticOrder>(F.lds, g, S, E, nullptr); }
    SEAM(3);
    if (IN(4)) phase_res(F, 0);
    SEAM(4);
    if (IN(5)) {
        { pg8::Gemm g{(const pg8::bf16_t*)(F.ws + WS_WIN), Hb, NHY, MROWS, D}; pg8::StaticOrder S; S.init(NHY, MROWS, F.G, (int)blockIdx.x);
          pg8::EpiBf16<0> E{(pg8::bf16_t*)(F.ws + WS_PT), MROWS, nullptr, 0, 0}; pg8::gemm_phase<pg8::EpiBf16<0>, pg8::StaticOrder>(F.lds, g, S, E, nullptr); }
        { pg8::Gemm g{Hb, (const pg8::bf16_t*)(F.ws + WS_WIN) + (size_t)NHY * D, MROWS, NGD, D}; pg8::StaticOrder S; S.init(MROWS, NGD, F.G, (int)blockIdx.x);
          pg8::EpiBf16<0> E{(pg8::bf16_t*)(F.ws + WS_PG), NGD, nullptr, 0, 0}; pg8::gemm_phase<pg8::EpiBf16<0>, pg8::StaticOrder>(F.lds, g, S, E, nullptr); }
    }
    SEAM(5);
    if (IN(6)) { for (int it = blockIdx.x; it < NITEM_PREP; it += F.G) gdn_prep_item(F, it); }
    SEAM(6);
    if (IN(7)) {
        for (;;) { __syncthreads(); if (F.tid == 0) *qslot = (int)atomicAdd(ctl, 1u); __syncthreads(); const int it = *qslot;
            if (it >= 1280 + 3072) break;
            if (it < 1280) gdn_scan_item(F, it); else hyena_item(F, it - 1280); }
    }
    SEAM(7);
    if (IN(8)) { __syncthreads(); for (int it = blockIdx.x; it < MROWS / 32; it += F.G) hy_out_item(F, it); gdn_out_rows(F); }
    SEAM(8);
    if (IN(9)) { pg8::Gemm g{Hb, (const pg8::bf16_t*)(F.ws + WS_WOUT), MROWS, D, D}; pg8::StaticOrder S; S.init(MROWS, D, F.G, (int)blockIdx.x);
        pg8::EpiF32 E{(float*)(F.ws + WS_Y), D, nullptr}; pg8::gemm_phase<pg8::EpiF32, pg8::StaticOrder>(F.lds, g, S, E, nullptr); }
    SEAM(9);
    if (IN(10)) { phase_res(F, 1); __syncthreads(); conv_ffn(F, 1); }
    SEAM(10);
    if (IN(11)) { pg8::Gemm g{Hb, (const pg8::bf16_t*)(F.ws + WS_FFGU), MROWS, 2 * FF, D}; pg8::StaticOrder S; S.init(MROWS, 2 * FF, F.G, (int)blockIdx.x);
        pg8::EpiSwiglu E{(pg8::bf16_t*)(F.ws + WS_ACT), FF}; pg8::gemm_phase<pg8::EpiSwiglu, pg8::StaticOrder>(F.lds, g, S, E, nullptr); }
    SEAM(11);
    if (IN(12)) { pg8::Gemm g{(const pg8::bf16_t*)(F.ws + WS_ACT), (const pg8::bf16_t*)(F.ws + WS_FFD), MROWS, D, FF}; pg8::StaticOrder S; S.init(MROWS, D, F.G, (int)blockIdx.x);
        pg8::EpiF32 E{(float*)(F.ws + WS_Y), D, nullptr}; pg8::gemm_phase<pg8::EpiF32, pg8::StaticOrder>(F.lds, g, S, E, nullptr); }
    SEAM(12);
    if (IN(13)) phase_res(F, 2);
#undef IN
#undef SEAM
}

extern "C" void kernel_launch(void* const* d_in, const int* in_sizes, int n_in, void* d_out, int out_size, void* d_ws, size_t ws_size, hipStream_t stream) {
    static int grid = 0;
    if (grid == 0) {
        int dev = 0, cus = 0, per_cu = 0;
        if (n_in != 27 || ws_size < WS_END) { fprintf(stderr, "kernel_launch: need 27 inputs and %zu bytes of workspace (got %d, %zu)\n", (size_t)WS_END, n_in, ws_size); grid = -1; return; }
        hipGetDevice(&dev); hipDeviceGetAttribute(&cus, hipDeviceAttributeMultiprocessorCount, dev);
        if (hipFuncSetAttribute((const void*)fwd_kernel, hipFuncAttributeMaxDynamicSharedMemorySize, LDS_BYTES) != hipSuccess) { fprintf(stderr, "kernel_launch: hipFuncSetAttribute failed\n"); grid = -1; return; }
        if (hipOccupancyMaxActiveBlocksPerMultiprocessor(&per_cu, (const void*)fwd_kernel, NT, LDS_BYTES) != hipSuccess || per_cu < 1) { fprintf(stderr, "kernel_launch: occupancy query says %d\n", per_cu); per_cu = 1; }
        (void)hipGetLastError();
        grid = cus * 1;
        fprintf(stderr, "kernel_launch: grid %d (per_cu %d), ws %zu need %zu\n", grid, per_cu, ws_size, (size_t)WS_END);
    }
    if (grid < 0) return;
    Args a{};
    for (int i = 0; i < 27; ++i) a.in[i] = (const float*)d_in[i];
    a.out = (float*)d_out; a.ws = (unsigned char*)d_ws;
#if ONE_LAUNCH
    a.ph_lo = 0; a.ph_hi = N_PHASES;
    { void* kargs[] = {&a}; hipError_t e = hipLaunchCooperativeKernel((const void*)fwd_kernel, dim3(grid), dim3(NT), kargs, LDS_BYTES, stream);
      if (e != hipSuccess) fprintf(stderr, "cooperative launch failed: %s\n", hipGetErrorString(e)); }
#else
    for (int p = 0; p < N_PHASES; ++p) { a.ph_lo = p; a.ph_hi = p + 1; void* kargs[] = {&a};
        hipError_t e = hipLaunchCooperativeKernel((const void*)fwd_kernel, dim3(grid), dim3(NT), kargs, LDS_BYTES, stream);
        if (e != hipSuccess) { fprintf(stderr, "launch %d failed: %s\n", p, hipGetErrorString(e)); break; } }
#endif
}
```

```cpp
#define ONE_LAUNCH 1
#include <hip/hip_runtime.h>
namespace pg8 {
#define PG8_LAS __attribute__((address_space(3)))
typedef unsigned short bf16_t;
typedef short bf16x8 __attribute__((ext_vector_type(8)));
typedef float f32x4 __attribute__((ext_vector_type(4)));
typedef unsigned u32x4 __attribute__((ext_vector_type(4)));
constexpr int BM = 256, BK = 64, HALF = 128, HTB = HALF * BK * 2  , STAGE_BYTES = 8 * HTB, NXCD = 8, WGM = 8;

__host__ __device__ __forceinline__ int lds_byte(int r, int c) { const int st = (r >> 4) * 2 + (c >> 5), rr = r & 15, cc = c & 31, ob = rr * 64 + cc * 2; return st * 1024 + (ob ^ (((ob >> 9) & 1) << 5)); }
__host__ __device__ __forceinline__ void stage_rc(int b, int& R, int& C) { const int st = b / 1024, sb = b % 1024, swz = sb ^ (((sb >> 9) & 1) << 5); R = (st >> 1) * 16 + swz / 64; C = (st & 1) * 32 + (swz % 64) / 2; }
__host__ __device__ __forceinline__ int perm32(int rho) { const int n = rho >> 4, i = rho & 15; return 8 * (i >> 2) + 4 * n + (i & 3); }

struct Unit { int pm, pn, z; };
struct Gemm { int K, ld; };

struct StaticOrder {
    int nM, nN, nwg, G, c;
    __host__ __device__ void init(int M, int N, int G_, int c_) { nM = M / BM; nN = N / BM; nwg = nM * nN; G = G_; c = c_; }
    __host__ __device__ bool next(int i, Unit& u) const {
        const long L = (long)i * G + c; if (L >= nwg) return false;
        int wgid = (int)L; { const int q = nwg / NXCD, r = nwg % NXCD, xcd = wgid % NXCD, off = wgid / NXCD; wgid = (xcd < r ? xcd * (q + 1) : r * (q + 1) + (xcd - r) * q) + off; }
        const int nig = WGM * nN, gid = wgid / nig, fm = gid * WGM, gsz = (nM - fm) < WGM ? (nM - fm) : WGM;
        u.pm = fm + ((wgid % nig) % gsz); u.pn = (wgid % nig) / gsz; u.z = 0; return true;
    }
    __device__ __forceinline__ void a_ready(const Unit&) const {}
    __device__ __forceinline__ void done(const Unit&) const {}
};
struct ZOrder {
    const char* A0; const char* B0; const char* A1; const char* B1; int nM0, nN0, nM1, nN1, nwg0, nwg, G, c;
    __device__ void init(const void* a0, const void* b0, int M0, int N0, const void* a1, const void* b1, int M1, int N1, int G_, int c_) {
        A0 = (const char*)a0; B0 = (const char*)b0; A1 = (const char*)a1; B1 = (const char*)b1; nM0 = M0 / BM; nN0 = N0 / BM; nM1 = M1 / BM; nN1 = N1 / BM; nwg0 = nM0 * nN0; nwg = nwg0 + nM1 * nN1; G = G_; c = c_; }
    __device__ bool next(int i, Unit& u) const {
        const long L = (long)i * G + c; if (L >= nwg) return false;
        const int z = L >= nwg0 ? 1 : 0; int wgid = (int)L - (z ? nwg0 : 0); const int nM = z ? nM1 : nM0, nN = z ? nN1 : nN0, nw = nM * nN;
        { const int q = nw / NXCD, r = nw % NXCD, xcd = wgid % NXCD, off = wgid / NXCD; wgid = (xcd < r ? xcd * (q + 1) : r * (q + 1) + (xcd - r) * q) + off; }
        const int nig = WGM * nN, gid = wgid / nig, fm = gid * WGM, gsz = (nM - fm) < WGM ? (nM - fm) : WGM;
        u.pm = fm + ((wgid % nig) % gsz); u.pn = (wgid % nig) / gsz; u.z = z; return true;
    }
    __device__ __forceinline__ void ptrs(const Unit& u, size_t tstep, const char*& a, const char*& b) const { a = (u.z ? A1 : A0) + (size_t)u.pm * tstep; b = (u.z ? B1 : B0) + (size_t)u.pn * tstep; }
    __device__ __forceinline__ void a_ready(const Unit&) const {}
    __device__ __forceinline__ void done(const Unit&) const {}
};
struct CountedOrder : StaticOrder {
    const unsigned* ready; unsigned need; unsigned* tmo;
    __device__ __forceinline__ void a_ready(const Unit& u) const {
        if (threadIdx.x < 64) {
            const unsigned long long t0 = __builtin_amdgcn_s_memrealtime(); unsigned polls = 0;
            while ((unsigned)__builtin_amdgcn_readfirstlane(__hip_atomic_load(ready + 64 * u.pm, __ATOMIC_RELAXED, __HIP_MEMORY_SCOPE_AGENT)) < need) {
                if ((++polls & 255u) == 0u && __builtin_amdgcn_readfirstlane(__hip_atomic_load(tmo, __ATOMIC_RELAXED, __HIP_MEMORY_SCOPE_AGENT)) != 0u) break;
                if (__builtin_amdgcn_s_memrealtime() - t0 > 2000000ull) {
                    if (threadIdx.x == 0) { unsigned expect = 0u; __hip_atomic_compare_exchange_strong(tmo + 1, &expect, 0x600u | (unsigned)(u.pm & 0xff), __ATOMIC_RELAXED, __ATOMIC_RELAXED, __HIP_MEMORY_SCOPE_AGENT); __hip_atomic_store(tmo, 1u, __ATOMIC_RELAXED, __HIP_MEMORY_SCOPE_AGENT); }
                    break; }
                __builtin_amdgcn_s_sleep(2); }
            __builtin_amdgcn_fence(__ATOMIC_ACQUIRE, "agent");
            asm volatile("s_waitcnt vmcnt(0)" ::: "memory");
        }
#if !defined(BROKEN_HOOK_NO_BARRIER)
        asm volatile("" ::: "memory"); __builtin_amdgcn_s_barrier(); asm volatile("" ::: "memory");
#endif
    }
};

__device__ __forceinline__ unsigned cvt_pk_bf16(float lo, float hi) { unsigned r; asm volatile("v_cvt_pk_bf16_f32 %0, %1, %2" : "=v"(r) : "v"(lo), "v"(hi)); return r; }
typedef float f32x2 __attribute__((ext_vector_type(2)));
__device__ __forceinline__ f32x2 gelu_pk(f32x2 v) {
    const f32x2 av = __builtin_elementwise_abs(v), d = av * 0.2316418882f + 1.0f;
    f32x2 t; t.x = __builtin_amdgcn_rcpf(d.x); t.y = __builtin_amdgcn_rcpf(d.y);
    f32x2 q = t * 0.5307027145f + (-0.7265760135f); q = q * t + 0.7107068705f; q = q * t + (-0.142248368f); q = q * t + 0.127414796f; q = q * t;
    const f32x2 s = (v * v) * (-0.72134752044f);
    f32x2 e; e.x = __builtin_amdgcn_exp2f(s.x); e.y = __builtin_amdgcn_exp2f(s.y);
    const f32x2 m = v * (q * e), r = v - m;
    f32x2 o; o.x = v.x < 0.f ? m.x : r.x; o.y = v.y < 0.f ? m.y : r.y; return o;
}

struct EpiF32 {
    static constexpr bool PERM = false, AFTER_DRAIN = false;
    float* C; int ldc; const float* bias; float* C1;
    __device__ __forceinline__ void operator()(const f32x4 (&acc)[2][2][4][2], const Unit& u, int wr, int wc, int fr, int fq) const {
        const int row0 = u.pm * BM + wr * 64 + fr, col0 = u.pn * BM + wc * 32 + 4 * fq;
        f32x4 bv[2][2];
#pragma unroll
        for (int bj = 0; bj < 2; ++bj)
#pragma unroll
            for (int n = 0; n < 2; ++n) bv[bj][n] = bias ? *(const f32x4*)(bias + col0 + bj * HALF + n * 16) : (f32x4){0.f, 0.f, 0.f, 0.f};
#pragma unroll
        for (int ai = 0; ai < 2; ++ai)
#pragma unroll
            for (int m = 0; m < 4; ++m) { float* rowp = (u.z ? C1 : C) + (size_t)(row0 + ai * HALF + m * 16) * ldc + col0;
#pragma unroll
                for (int bj = 0; bj < 2; ++bj)
#pragma unroll
                    for (int n = 0; n < 2; ++n) *(f32x4*)(rowp + bj * HALF + n * 16) = acc[ai][bj][m][n] + bv[bj][n]; }
    }
};
template <int ACT  > struct EpiBf16 {
    static constexpr bool PERM = true, AFTER_DRAIN = false;
    bf16_t* O; int ldc; const float* bias; int split_cols; size_t split_stride; bf16_t* O1; int ldc1;
    __device__ __forceinline__ void operator()(const f32x4 (&acc)[2][2][4][2], const Unit& u, int wr, int wc, int fr, int fq) const {
        const int row0 = u.pm * BM + wr * 64 + fr; int colt = u.pn * BM; bf16_t* base = u.z ? O1 : O; const int ldc = u.z ? ldc1 : this->ldc;
        if (split_cols) { const int t = colt / split_cols; base += (size_t)t * split_stride; colt -= t * split_cols; }
        const int col0 = colt + wc * 32 + 8 * fq, bcol0 = u.pn * BM + wc * 32 + 8 * fq;
        f32x4 bv[2][2];
#pragma unroll
        for (int bj = 0; bj < 2; ++bj)
#pragma unroll
            for (int n = 0; n < 2; ++n) bv[bj][n] = bias ? *(const f32x4*)(bias + bcol0 + bj * HALF + 4 * n) : (f32x4){0.f, 0.f, 0.f, 0.f};
#pragma unroll
        for (int ai = 0; ai < 2; ++ai)
#pragma unroll
            for (int m = 0; m < 4; ++m) { bf16_t* rowp = base + (size_t)(row0 + ai * HALF + m * 16) * ldc + col0;
#pragma unroll
                for (int bj = 0; bj < 2; ++bj) { f32x4 v0 = acc[ai][bj][m][0] + bv[bj][0], v1 = acc[ai][bj][m][1] + bv[bj][1];
                    if (ACT == 1) { f32x2 a = gelu_pk((f32x2){v0[0], v0[1]}), b = gelu_pk((f32x2){v0[2], v0[3]}), c = gelu_pk((f32x2){v1[0], v1[1]}), d = gelu_pk((f32x2){v1[2], v1[3]});
                        v0 = (f32x4){a.x, a.y, b.x, b.y}; v1 = (f32x4){c.x, c.y, d.x, d.y}; }
                    if (ACT == 2) {
#pragma unroll
                        for (int j = 0; j < 4; ++j) { v0[j] = 0.5f * v0[j] * (1.0f + erff(v0[j] * 0.70710678f)); v1[j] = 0.5f * v1[j] * (1.0f + erff(v1[j] * 0.70710678f)); } }
                    u32x4 w; w.x = cvt_pk_bf16(v0[0], v0[1]); w.y = cvt_pk_bf16(v0[2], v0[3]); w.z = cvt_pk_bf16(v1[0], v1[1]); w.w = cvt_pk_bf16(v1[2], v1[3]);
                    *(u32x4*)(rowp + bj * HALF) = w; } }
    }
};

struct EpiSwiglu {
    static constexpr bool PERM = true, AFTER_DRAIN = false;
    bf16_t* O; int ldc;
    __device__ __forceinline__ float sg(float g, float u) const { return g * __builtin_amdgcn_rcpf(1.0f + __builtin_amdgcn_exp2f(-1.44269504089f * g)) * u; }
    __device__ __forceinline__ void operator()(const f32x4 (&acc)[2][2][4][2], const Unit& u, int wr, int wc, int fr, int fq) const {
        const int row0 = u.pm * BM + wr * 64 + fr, col0 = u.pn * HALF + wc * 32 + 8 * fq;
#pragma unroll
        for (int ai = 0; ai < 2; ++ai)
#pragma unroll
            for (int m = 0; m < 4; ++m) { bf16_t* rowp = O + (size_t)(row0 + ai * HALF + m * 16) * ldc + col0;
                const f32x4 g0 = acc[ai][0][m][0], g1 = acc[ai][0][m][1], u0 = acc[ai][1][m][0], u1 = acc[ai][1][m][1];
                u32x4 w; w.x = cvt_pk_bf16(sg(g0[0], u0[0]), sg(g0[1], u0[1])); w.y = cvt_pk_bf16(sg(g0[2], u0[2]), sg(g0[3], u0[3]));
                w.z = cvt_pk_bf16(sg(g1[0], u1[0]), sg(g1[1], u1[1])); w.w = cvt_pk_bf16(sg(g1[2], u1[2]), sg(g1[3], u1[3]));
                *(u32x4*)rowp = w; }
    }
};
template <class Epi, class Sched, bool STAMP = false>
__device__ __forceinline__ void gemm_phase(PG8_LAS unsigned char* lds, const Gemm g, const Sched& S, const Epi& E, unsigned long long* stamps) {
    const int tid = threadIdx.x, wid = __builtin_amdgcn_readfirstlane(tid >> 6), lane = tid & 63, wr = wid >> 2, wc = wid & 3, fr = lane & 15, fq = lane >> 4;
    const int K = g.K, nt = K / BK, ld = g.ld;
    int ts_lo = 0, ts_hi = 0, nts = 0; const unsigned long long rt_entry = STAMP ? (unsigned long long)wall_clock64() : 0ull;
#define PG8_STAMP() do { if (STAMP && wid == 0 && nts < 64) { const unsigned long long _c = (unsigned long long)clock64(); \
        ts_lo = (lane == nts) ? (int)(unsigned)_c : ts_lo; ts_hi = (lane == nts) ? (int)(unsigned)(_c >> 32) : ts_hi; ++nts; } } while (0)
    PG8_STAMP();
    unsigned voffA[2], voffB[2];
#pragma unroll
    for (int i = 0; i < 2; ++i) { int R, C; stage_rc(tid * 16 + i * 8192, R, C); const int Rb = Epi::PERM ? ((R & ~31) + perm32(R & 31)) : R;
        voffA[i] = (unsigned)(R * ld + C) * 2u; voffB[i] = (unsigned)(Rb * ld + C) * 2u; }
    const size_t kstep = (size_t)(BK * 2);
    const size_t hstep = (size_t)HALF * ld * 2;
    const size_t tstep = 2 * hstep;
    const unsigned ldsw = (unsigned)wid * 1024u;
    const int aoff = lds_byte(wr * 64 + fr, fq * 8), boff = lds_byte(wc * 32 + fr, fq * 8);
#define PG8_SA(b, h) (((b) * 2 + (h)) * HTB)
#define PG8_SB(b, h) ((4 + (b) * 2 + (h)) * HTB)
#define PG8_STAGE(bufoff, gbase, voff) do { _Pragma("unroll") for (int _i = 0; _i < 2; ++_i) \
        __builtin_amdgcn_global_load_lds((const unsigned*)((const char*)(gbase) + (voff)[_i]), (PG8_LAS unsigned*)(lds + (bufoff) + ldsw + _i * 8192), 16, 0, 0); } while (0)
#define PG8_LDA(dst, b, h) do { _Pragma("unroll") for (int m = 0; m < 4; ++m) _Pragma("unroll") for (int k = 0; k < 2; ++k) dst[m][k] = *(const PG8_LAS bf16x8*)(lds + PG8_SA(b, h) + aoff + m * 2048 + k * 1024); } while (0)
#define PG8_LDB(dst, b, h) do { _Pragma("unroll") for (int n = 0; n < 2; ++n) _Pragma("unroll") for (int k = 0; k < 2; ++k) dst[n][k] = *(const PG8_LAS bf16x8*)(lds + PG8_SB(b, h) + boff + n * 2048 + k * 1024); } while (0)
#define PG8_MMA(ai, bj, At, Bt) do { __builtin_amdgcn_s_setprio(1); _Pragma("unroll") for (int m = 0; m < 4; ++m) _Pragma("unroll") for (int n = 0; n < 2; ++n) _Pragma("unroll") for (int k = 0; k < 2; ++k) \
        acc[ai][bj][m][n] = __builtin_amdgcn_mfma_f32_16x16x32_bf16(Bt[n][k], At[m][k], acc[ai][bj][m][n], 0, 0, 0); __builtin_amdgcn_s_setprio(0); } while (0)
#define PG8_WAIT_V(n) asm volatile("s_waitcnt vmcnt(" #n ")" ::: "memory")
#define PG8_WAIT_L(n) asm volatile("s_waitcnt lgkmcnt(" #n ")" ::: "memory")
#define PG8_BAR __builtin_amdgcn_s_barrier()
#define PG8_SCHED __builtin_amdgcn_sched_barrier(0)
    Unit cur, nxt; int ui = 0;
    if (!S.next(0, cur)) return;
    f32x4 acc[2][2][4][2];
#pragma unroll
    for (int a = 0; a < 2; ++a)
#pragma unroll
        for (int b = 0; b < 2; ++b)
#pragma unroll
            for (int m = 0; m < 4; ++m)
#pragma unroll
                for (int n = 0; n < 2; ++n) acc[a][b][m][n] = (f32x4){0.f, 0.f, 0.f, 0.f};
    bf16x8 At[4][2], B0[2][2], B1[2][2];
    const char* cA; const char* cB; S.ptrs(cur, tstep, cA, cB);
    S.a_ready(cur);
    PG8_STAGE(PG8_SB(0, 0), cB, voffB); PG8_STAGE(PG8_SB(0, 1), cB + hstep, voffB); PG8_STAGE(PG8_SA(0, 0), cA, voffA); PG8_STAGE(PG8_SA(0, 1), cA + hstep, voffA);
    if (wr == 1) PG8_BAR;
    PG8_WAIT_V(2); PG8_BAR;
    PG8_STAGE(PG8_SB(1, 0), cB + kstep, voffB); PG8_STAGE(PG8_SA(1, 0), cA + kstep, voffA); PG8_STAGE(PG8_SB(1, 1), cB + hstep + kstep, voffB);
    PG8_WAIT_V(6); PG8_BAR;
    PG8_STAMP();
    for (;;) {
        const bool has_next = S.next(ui + 1, nxt);
        const char* nA = cA; const char* nB = cB; if (has_next) S.ptrs(nxt, tstep, nA, nB);
        for (int t = 0; t < nt; t += 2) {
            const bool last = (t == nt - 2);
            const char* a1 = cA + (size_t)(t + 1) * kstep;
            const char* a2 = last ? nA : cA + (size_t)(t + 2) * kstep; const char* b2 = last ? nB : cB + (size_t)(t + 2) * kstep;
            const char* a3 = a2 + kstep; const char* b3 = b2 + kstep;
            if (last && has_next) S.a_ready(nxt);
            PG8_LDB(B0, 0, 0); PG8_LDB(B1, 0, 1); PG8_SCHED; PG8_LDA(At, 0, 0); PG8_STAGE(PG8_SA(1, 1), a1 + hstep, voffA);
            PG8_WAIT_V(8); PG8_WAIT_L(0); PG8_BAR; PG8_MMA(0, 0, At, B0); PG8_MMA(0, 1, At, B1); PG8_BAR; PG8_SCHED;
            PG8_LDA(At, 0, 1); PG8_STAGE(PG8_SB(0, 0), b2, voffB); PG8_STAGE(PG8_SB(0, 1), b2 + hstep, voffB); PG8_STAGE(PG8_SA(0, 0), a2, voffA);
            PG8_WAIT_V(8); PG8_WAIT_L(0); PG8_BAR; PG8_MMA(1, 0, At, B0); PG8_MMA(1, 1, At, B1); PG8_BAR; PG8_SCHED;
            PG8_LDB(B0, 1, 0); PG8_LDB(B1, 1, 1); PG8_SCHED; PG8_LDA(At, 1, 0); PG8_STAGE(PG8_SA(0, 1), a2 + hstep, voffA);
            PG8_WAIT_V(8); PG8_WAIT_L(0); PG8_BAR; PG8_MMA(0, 0, At, B0); PG8_MMA(0, 1, At, B1); PG8_BAR; PG8_SCHED;
            PG8_LDA(At, 1, 1); PG8_STAGE(PG8_SB(1, 0), b3, voffB); PG8_STAGE(PG8_SB(1, 1), b3 + hstep, voffB); PG8_STAGE(PG8_SA(1, 0), a3, voffA);
            PG8_WAIT_V(8); PG8_WAIT_L(0); PG8_BAR; PG8_MMA(1, 0, At, B0); PG8_MMA(1, 1, At, B1); PG8_BAR; PG8_SCHED;
        }
        PG8_STAMP();
        if (wr == 0) PG8_BAR;
        if constexpr (!Epi::AFTER_DRAIN) { E(acc, cur, wr, wc, fr, fq); S.done(cur); }
        PG8_STAMP();
        if (!has_next) break;
#pragma unroll
        for (int a = 0; a < 2; ++a)
#pragma unroll
            for (int b = 0; b < 2; ++b)
#pragma unroll
                for (int m = 0; m < 4; ++m)
#pragma unroll
                    for (int n = 0; n < 2; ++n) acc[a][b][m][n] = (f32x4){0.f, 0.f, 0.f, 0.f};
        cur = nxt; cA = nA; cB = nB; ++ui;
        if (wr == 1) PG8_BAR;
    }
    PG8_WAIT_V(0);
    PG8_BAR;
    if constexpr (Epi::AFTER_DRAIN) { E.fused(acc, cur, wr, wc, fr, fq, lds, wid, lane); S.done(cur); }
    PG8_STAMP();
    if (STAMP && wid == 0) { stamps[lane] = lane < nts ? (((unsigned long long)(unsigned)ts_hi << 32) | (unsigned)ts_lo) : 0ull;
        if (lane == 62) stamps[62] = rt_entry; if (lane == 63) stamps[63] = (unsigned long long)wall_clock64(); }
#undef PG8_STAMP
#undef PG8_SA
#undef PG8_SB
#undef PG8_STAGE
#undef PG8_LDA
#undef PG8_LDB
#undef PG8_MMA
#undef PG8_WAIT_V
#undef PG8_WAIT_L
#undef PG8_BAR
#undef PG8_SCHED
}
}

#include <hip/hip_cooperative_groups.h>
#include <cstdio>
namespace cg = cooperative_groups;
#define LAS __attribute__((address_space(3)))
typedef float f4 __attribute__((ext_vector_type(4)));
typedef float f2 __attribute__((ext_vector_type(2)));
typedef unsigned u4 __attribute__((ext_vector_type(4)));
typedef unsigned u2 __attribute__((ext_vector_type(2)));
typedef unsigned short u16;
typedef short bf8 __attribute__((ext_vector_type(8)));
typedef float f16v __attribute__((ext_vector_type(16)));
#define MFMA32(a, b, c) __builtin_amdgcn_mfma_f32_32x32x16_bf16((a), (b), (c), 0, 0, 0)

constexpr int D = 2048, FF = 5632, MROWS = 12288, MCTX = 4096;
constexpr int NHY = 3072, NGD = 4352, NWIN = 7200, NWINP = 7424;
constexpr int NT = 512;
constexpr int LDS_BYTES = 163840;
constexpr int NITEM_PREP = 1536;
constexpr float RMS_EPS = 1e-6f;

constexpr size_t al256(size_t x) { return (x + 255) & ~(size_t)255; }
constexpr size_t WS_WIN = 0;
constexpr size_t WS_WOUT = WS_WIN + (size_t)NWINP * D * 2;
constexpr size_t WS_FFGU = WS_WOUT + (size_t)D * D * 2;
constexpr size_t WS_FFD = WS_FFGU + (size_t)2 * FF * D * 2;
constexpr size_t WS_FFEND = WS_FFD + (size_t)D * FF * 2;
constexpr size_t WS_H = WS_FFEND;
constexpr size_t WS_MOD = WS_H + (size_t)MROWS * D * 2;
constexpr size_t WS_CTL = WS_MOD + al256((size_t)5 * 18432 * 4);
constexpr size_t WS_BAR = WS_CTL + 256;
constexpr size_t WS_H2TAB = WS_BAR + 16384;
constexpr size_t WS_HSC = WS_H2TAB + (size_t)2304 * 64 * 4;
constexpr size_t WS_HSL = WS_HSC + (size_t)2 * 1024 * 512 * 8;
constexpr size_t WS_D = WS_HSL + (size_t)2 * 1024 * 4096 * 8;
constexpr size_t WS_ACT = WS_D;
constexpr size_t WS_Y = WS_D + (size_t)MROWS * FF * 2;
constexpr size_t WS_Y1 = WS_Y + (size_t)MROWS * D * 4;
constexpr size_t WS_PT = WS_D;
constexpr size_t WS_PG = WS_PT + (size_t)NHY * MROWS * 2;
constexpr size_t WS_QN = WS_PG + (size_t)MROWS * NGD * 2;
constexpr size_t WS_KN = WS_QN + (size_t)MROWS * 1024 * 2;
constexpr size_t WS_W = WS_KN + (size_t)2 * MROWS * 1024 * 2;
constexpr size_t WS_U = WS_W + (size_t)2 * MROWS * 1024 * 2;
constexpr size_t WS_END = WS_U + (size_t)2 * MROWS * 1024 * 2;
constexpr size_t WS_OF = WS_PG;
constexpr size_t WS_OB = WS_OF + (size_t)MROWS * 1024 * 2;
constexpr size_t WS_ZHT = WS_OB + (size_t)MROWS * 1024 * 2;
static_assert(WS_ZHT + (size_t)1024 * MROWS * 4 <= WS_QN, "P7 outputs must fit the PG region");
static_assert(WS_Y1 + (size_t)MROWS * D * 4 <= WS_END, "Y fits");
constexpr size_t WS_SZ = WS_FFGU;
constexpr size_t WS_ATT = WS_SZ + (size_t)MROWS * 1024 * 2;
constexpr size_t WS_GC = WS_ATT + (size_t)2 * NITEM_PREP * 4096 * 2;
static_assert(WS_GC + (size_t)2 * NITEM_PREP * 64 * 4 <= WS_FFEND, "P6 extras fit the FFN weight region");

struct Args { const float* in[27]; float* out; unsigned char* ws; int ph_lo, ph_hi; };

struct Frame {
    const float *x_prompt, *x_sample, *state, *cvec, *cctx, *ada_w, *ada_b, *npre, *npost, *wg, *wu, *wd, *w_in, *w_out;
    const float *hy_conv, *hw1, *hb1, *hw2, *hb2, *hw3, *hdecay, *hbias, *hnorm, *g_conv, *g_alog, *g_dtb, *g_onorm;
    float* out; unsigned char* ws;
    LAS unsigned char* lds;
    int tid, lane, wave, G;
};

__device__ __forceinline__ u16 f2bf(float f) { unsigned u = __float_as_uint(f); u += 0x7FFFu + ((u >> 16) & 1u); return (u16)(u >> 16); }
__device__ __forceinline__ float bf2f(unsigned b) { return __uint_as_float(b << 16); }
__device__ __forceinline__ unsigned pack2(float a, float b) { return (unsigned)f2bf(a) | ((unsigned)f2bf(b) << 16); }
__device__ __forceinline__ unsigned pack2h(float a, float b) { unsigned r; asm volatile("v_cvt_pk_bf16_f32 %0, %1, %2" : "=v"(r) : "v"(a), "v"(b)); return r; }
__device__ __forceinline__ float bflo(unsigned w) { return __uint_as_float(w << 16); }
__device__ __forceinline__ float bfhi(unsigned w) { return __uint_as_float(w & 0xffff0000u); }
__device__ __forceinline__ float wave_sum(float v) {
#pragma unroll
    for (int o = 32; o >= 1; o >>= 1) v += __shfl_xor(v, o);
    return v; }
__device__ __forceinline__ float silu_f(float x) { return x * __builtin_amdgcn_rcpf(1.0f + __expf(-x)); }
__device__ __forceinline__ int modidx(int r) { return r < MCTX ? 0 : 1 + ((r - MCTX) >> 11); }

struct CvJob { const float* src; u16* dst; int N, ldd, map, kt, nt; };
__device__ __forceinline__ void conv_load(const Frame& F, const CvJob& j, int slot, int tid) {
    LAS float* T = (LAS float*)F.lds + slot * (64 * 65);
    const int k0 = j.kt * 64, n0 = j.nt * 64;
#pragma unroll
    for (int p = 0; p < 2; ++p) { const int kr = (tid >> 4) + 32 * p, c4 = tid & 15, n = n0 + 4 * c4;
        f4 v = (f4){0.f, 0.f, 0.f, 0.f}; if (n < j.N) v = *(const f4*)(j.src + (size_t)(k0 + kr) * j.N + n);
        T[(4 * c4 + 0) * 65 + kr] = v[0]; T[(4 * c4 + 1) * 65 + kr] = v[1]; T[(4 * c4 + 2) * 65 + kr] = v[2]; T[(4 * c4 + 3) * 65 + kr] = v[3]; }
}
__device__ __forceinline__ void conv_store(const Frame& F, const CvJob& j, int slot, int tid) {
    LAS float* T = (LAS float*)F.lds + slot * (64 * 65);
    const int k0 = j.kt * 64, n0 = j.nt * 64, n = tid >> 3, seg = tid & 7, nn = n0 + n;
    if (nn < j.N) { const int row = j.map == 0 ? nn : ((nn >> 7) * 256 + (j.map - 1) * 128 + (nn & 127));
        u4 w; w.x = pack2(T[n * 65 + 8 * seg + 0], T[n * 65 + 8 * seg + 1]); w.y = pack2(T[n * 65 + 8 * seg + 2], T[n * 65 + 8 * seg + 3]);
        w.z = pack2(T[n * 65 + 8 * seg + 4], T[n * 65 + 8 * seg + 5]); w.w = pack2(T[n * 65 + 8 * seg + 6], T[n * 65 + 8 * seg + 7]);
        *(u4*)(j.dst + (size_t)row * j.ldd + k0 + 8 * seg) = w; }
}
__device__ __forceinline__ bool conv_job(const Frame& F, int which, int f, int t, CvJob& j) {
    if (which == 0) { if (t >= 3 * 2816) return false;
        if (t < 2816) { j.src = F.wg + (size_t)f * D * FF; j.dst = (u16*)(F.ws + WS_FFGU); j.N = FF; j.ldd = D; j.map = 1; j.kt = t / 88; j.nt = t % 88; }
        else if (t < 5632) { const int u = t - 2816; j.src = F.wu + (size_t)f * D * FF; j.dst = (u16*)(F.ws + WS_FFGU); j.N = FF; j.ldd = D; j.map = 2; j.kt = u / 88; j.nt = u % 88; }
        else { const int u = t - 5632; j.src = F.wd + (size_t)f * FF * D; j.dst = (u16*)(F.ws + WS_FFD); j.N = D; j.ldd = FF; j.map = 0; j.kt = u / 32; j.nt = u % 32; }
        return true; }
    if (t >= 32 * 113 + 1024) return false;
    if (t < 32 * 113) { j.src = F.w_in; j.dst = (u16*)(F.ws + WS_WIN); j.N = NWIN; j.ldd = D; j.map = 0; j.kt = t / 113; j.nt = t % 113; }
    else { const int u = t - 32 * 113; j.src = F.w_out; j.dst = (u16*)(F.ws + WS_WOUT); j.N = D; j.ldd = D; j.map = 0; j.kt = u / 32; j.nt = u % 32; }
    return true;
}
__device__ __forceinline__ void conv_run(const Frame& F, int which, int f) {
    int tid = F.tid; asm volatile("" : "+v"(tid));
    const int ntile = which == 0 ? 3 * 2816 : 32 * 113 + 1024;
    for (int t0 = blockIdx.x * 4; t0 < ntile; t0 += F.G * 4) {
        CvJob j0, j1, j2, j3;
        conv_job(F, which, f, min(t0 + 0, ntile - 1), j0); conv_job(F, which, f, min(t0 + 1, ntile - 1), j1); conv_job(F, which, f, min(t0 + 2, ntile - 1), j2); conv_job(F, which, f, min(t0 + 3, ntile - 1), j3);
        const int kr = tid >> 4, c4 = tid & 15;
        f4 v[8];
#define CV_LD(J, o) do { const int n = J.nt * 64 + 4 * c4; const bool ok = n < J.N; const float* sp = J.src + (size_t)(J.kt * 64 + kr) * J.N + (ok ? n : 0); \
            v[o] = *(const f4*)sp; v[o + 1] = *(const f4*)(sp + (size_t)32 * J.N); if (!ok) { v[o] = (f4){0.f, 0.f, 0.f, 0.f}; v[o + 1] = v[o]; } } while (0)
        CV_LD(j0, 0); CV_LD(j1, 2); CV_LD(j2, 4); CV_LD(j3, 6);
#undef CV_LD
        __syncthreads();
#pragma unroll
        for (int sl = 0; sl < 4; ++sl) { LAS float* T = (LAS float*)F.lds + sl * (64 * 65);
#pragma unroll
            for (int p = 0; p < 2; ++p) { const f4 x = v[2 * sl + p]; const int k = kr + 32 * p;
                T[(4 * c4 + 0) * 65 + k] = x[0]; T[(4 * c4 + 1) * 65 + k] = x[1]; T[(4 * c4 + 2) * 65 + k] = x[2]; T[(4 * c4 + 3) * 65 + k] = x[3]; } }
        __syncthreads();
        conv_store(F, j0, 0, tid); if (t0 + 1 < ntile) conv_store(F, j1, 1, tid); if (t0 + 2 < ntile) conv_store(F, j2, 2, tid); if (t0 + 3 < ntile) conv_store(F, j3, 3, tid);
    }
    __syncthreads();
}
__device__ __forceinline__ void conv_ffn(const Frame& F, int f) { conv_run(F, 0, f); }
__device__ __forceinline__ void conv_inout(const Frame& F) {
    conv_run(F, 1, 0);
    u16* win = (u16*)(F.ws + WS_WIN);
    for (size_t i = (size_t)blockIdx.x * NT + F.tid; i < (size_t)(NWINP - NWIN) * D / 8; i += (size_t)F.G * NT) *(u4*)(win + (size_t)NWIN * D + i * 8) = (u4){0u, 0u, 0u, 0u};
}
__device__ __forceinline__ void mod_gemv(const Frame& F) {
    LAS float* sv = (LAS float*)F.lds;
    LAS float* red = sv + 5 * 2048;
    const int tid = F.tid;
    for (int i = tid; i < 5 * 2048; i += NT) { const int v = i >> 11, k = i & 2047; const float c = v == 0 ? F.cctx[k] : F.cvec[(v - 1) * 2048 + k]; sv[i] = silu_f(c); }
    __syncthreads();
    float* mod = (float*)(F.ws + WS_MOD);
    for (int chunk = blockIdx.x; chunk < 256; chunk += F.G) {
        const int col0 = chunk * 72;
        if (tid < 504) { const int kg = tid / 18, cq = tid % 18;
            f4 a0 = (f4){0.f, 0.f, 0.f, 0.f}, a1 = a0, a2 = a0, a3 = a0, a4 = a0;
#pragma unroll 8
            for (int k = kg; k < 2048; k += 28) { const f4 w = *(const f4*)(F.ada_w + (size_t)k * 18432 + col0 + 4 * cq);
                a0 += sv[k] * w; a1 += sv[2048 + k] * w; a2 += sv[4096 + k] * w; a3 += sv[6144 + k] * w; a4 += sv[8192 + k] * w; }
            LAS float* rp = red + (kg * 18 + cq) * 20;
            *(LAS f4*)(rp + 0) = a0; *(LAS f4*)(rp + 4) = a1; *(LAS f4*)(rp + 8) = a2; *(LAS f4*)(rp + 12) = a3; *(LAS f4*)(rp + 16) = a4; }
        __syncthreads();
        if (tid < 360) { const int v = tid / 72, c = tid % 72, cq = c >> 2, j = c & 3; float s = 0.f;
            for (int kg = 0; kg < 28; ++kg) s += red[(kg * 18 + cq) * 20 + v * 4 + j];
            mod[v * 18432 + col0 + c] = s + F.ada_b[col0 + c]; }
        __syncthreads();
    }
}
__device__ __forceinline__ void filt_h2(const Frame& F) {
    float* tab = (float*)(F.ws + WS_H2TAB);
    for (int p = blockIdx.x * 8 + F.wave; p < 2304; p += F.G * 8) {
        int lane = F.lane; asm volatile("" : "+v"(lane));
        const int L = p < 256 ? 256 : 2048, idx = p < 256 ? p : p - 256;
        const float t = (float)idx / (float)(L - 1), invL = 1.0f / (float)L;
        float a = F.hb1[lane] + t * F.hw1[lane];
#pragma unroll
        for (int b = 1; b <= 16; ++b) { const int m = (idx * b) & (L - 1); const float rev = (float)m * invL;
            a += __builtin_amdgcn_cosf(rev) * F.hw1[b * 64 + lane] + __builtin_amdgcn_sinf(rev) * F.hw1[(16 + b) * 64 + lane]; }
        const float h1 = __sinf(a);
        float a2 = F.hb2[lane];
#pragma unroll 4
        for (int i = 0; i < 64; ++i) a2 += __shfl(h1, i) * F.hw2[i * 64 + lane];
        tab[p * 64 + lane] = __sinf(a2);
    }
}

#define PH(i) ((i) + ((i) >> 3))
__device__ __forceinline__ f2 cmul(f2 a, f2 b) { return (f2){a.x * b.x - a.y * b.y, a.x * b.y + a.y * b.x}; }
__device__ __forceinline__ f2 cmt(f2 a, f2 w, f2 wp) { return w * a.x + wp * a.y; }
__device__ __forceinline__ f2 perp(f2 w) { return (f2){-w.y, w.x}; }
__device__ __forceinline__ void dif8(f2 (&x)[8], f2 w1) {
    const f2 w2 = cmul(w1, w1), w4 = cmul(w2, w2); const float r = 0.70710678118654752f;
    const f2 tA1 = (f2){(w1.x + w1.y) * r, (w1.y - w1.x) * r}, tA2 = (f2){w1.y, -w1.x}, tA3 = (f2){(w1.y - w1.x) * r, -(w1.x + w1.y) * r}, tB1 = (f2){w2.y, -w2.x};
    const f2 w1p = perp(w1), tA1p = perp(tA1), tA2p = perp(tA2), tA3p = perp(tA3), w2p = perp(w2), tB1p = perp(tB1), w4p = perp(w4);
    { f2 a = x[0], b = x[4]; x[0] = a + b; x[4] = cmt(a - b, w1, w1p); a = x[1]; b = x[5]; x[1] = a + b; x[5] = cmt(a - b, tA1, tA1p);
      a = x[2]; b = x[6]; x[2] = a + b; x[6] = cmt(a - b, tA2, tA2p); a = x[3]; b = x[7]; x[3] = a + b; x[7] = cmt(a - b, tA3, tA3p); }
#pragma unroll
    for (int o = 0; o < 8; o += 4) { f2 a = x[o], b = x[o + 2]; x[o] = a + b; x[o + 2] = cmt(a - b, w2, w2p); a = x[o + 1]; b = x[o + 3]; x[o + 1] = a + b; x[o + 3] = cmt(a - b, tB1, tB1p); }
#pragma unroll
    for (int m = 0; m < 8; m += 2) { const f2 a = x[m], b = x[m + 1]; x[m] = a + b; x[m + 1] = cmt(a - b, w4, w4p); }
}
__device__ __forceinline__ void dif8z(f2 (&x)[8], f2 w1) {
    const f2 w2 = cmul(w1, w1), w4 = cmul(w2, w2); const float r = 0.70710678118654752f;
    const f2 tA1 = (f2){(w1.x + w1.y) * r, (w1.y - w1.x) * r}, tA2 = (f2){w1.y, -w1.x}, tA3 = (f2){(w1.y - w1.x) * r, -(w1.x + w1.y) * r}, tB1 = (f2){w2.y, -w2.x};
    const f2 w1p = perp(w1), tA1p = perp(tA1), tA2p = perp(tA2), tA3p = perp(tA3), w2p = perp(w2), tB1p = perp(tB1), w4p = perp(w4);
    x[4] = cmt(x[0], w1, w1p); x[5] = cmt(x[1], tA1, tA1p); x[6] = cmt(x[2], tA2, tA2p); x[7] = cmt(x[3], tA3, tA3p);
#pragma unroll
    for (int o = 0; o < 8; o += 4) { f2 a = x[o], b = x[o + 2]; x[o] = a + b; x[o + 2] = cmt(a - b, w2, w2p); a = x[o + 1]; b = x[o + 3]; x[o + 1] = a + b; x[o + 3] = cmt(a - b, tB1, tB1p); }
#pragma unroll
    for (int m = 0; m < 8; m += 2) { const f2 a = x[m], b = x[m + 1]; x[m] = a + b; x[m + 1] = cmt(a - b, w4, w4p); }
}
__device__ __forceinline__ void dit8(f2 (&x)[8], f2 v1) {
    const f2 v2 = cmul(v1, v1), v4 = cmul(v2, v2); const float r = 0.70710678118654752f;
    const f2 tA1 = (f2){(v1.x - v1.y) * r, (v1.x + v1.y) * r}, tA2 = (f2){-v1.y, v1.x}, tA3 = (f2){-(v1.x + v1.y) * r, (v1.x - v1.y) * r}, tB1 = (f2){-v2.y, v2.x};
    const f2 v1p = perp(v1), tA1p = perp(tA1), tA2p = perp(tA2), tA3p = perp(tA3), v2p = perp(v2), tB1p = perp(tB1), v4p = perp(v4);
#pragma unroll
    for (int m = 0; m < 8; m += 2) { const f2 a = x[m], t = cmt(x[m + 1], v4, v4p); x[m] = a + t; x[m + 1] = a - t; }
#pragma unroll
    for (int o = 0; o < 8; o += 4) { f2 a = x[o], t = cmt(x[o + 2], v2, v2p); x[o] = a + t; x[o + 2] = a - t; a = x[o + 1]; t = cmt(x[o + 3], tB1, tB1p); x[o + 1] = a + t; x[o + 3] = a - t; }
    { f2 a = x[0], t = cmt(x[4], v1, v1p); x[0] = a + t; x[4] = a - t; a = x[1]; t = cmt(x[5], tA1, tA1p); x[1] = a + t; x[5] = a - t;
      a = x[2]; t = cmt(x[6], tA2, tA2p); x[2] = a + t; x[6] = a - t; a = x[3]; t = cmt(x[7], tA3, tA3p); x[3] = a + t; x[7] = a - t; }
}
constexpr int ZS = 4608;
template <int NB> __device__ __forceinline__ void fft_fwd(LAS f2* Z, int Nf, int tid) {
    for (int q = Nf >> 3; q >= 1; q >>= 3) {
        __syncthreads();
        const int jp = tid & (q - 1), base = ((tid - jp) << 3) + jp; const float rev = (float)jp / (float)(8 * q);
        const f2 w1 = (f2){__builtin_amdgcn_cosf(rev), -__builtin_amdgcn_sinf(rev)};
        f2 x[NB][8];
#pragma unroll
        for (int b = 0; b < NB; ++b)
#pragma unroll
            for (int m = 0; m < 8; ++m) x[b][m] = Z[b * ZS + PH(base + m * q)];
#pragma unroll
        for (int b = 0; b < NB; ++b) dif8(x[b], w1);
#pragma unroll
        for (int b = 0; b < NB; ++b)
#pragma unroll
            for (int m = 0; m < 8; ++m) Z[b * ZS + PH(base + m * q)] = x[b][m];
    }
    __syncthreads();
}
template <int NB> __device__ __forceinline__ void fft_inv(LAS f2* Z, int Nf, int tid) {
    for (int q = 1; q <= (Nf >> 3); q <<= 3) {
        __syncthreads();
        const int jp = tid & (q - 1), base = ((tid - jp) << 3) + jp; const float rev = (float)jp / (float)(8 * q);
        const f2 v1 = (f2){__builtin_amdgcn_cosf(rev), __builtin_amdgcn_sinf(rev)};
        f2 x[NB][8];
#pragma unroll
        for (int b = 0; b < NB; ++b)
#pragma unroll
            for (int m = 0; m < 8; ++m) x[b][m] = Z[b * ZS + PH(base + m * q)];
#pragma unroll
        for (int b = 0; b < NB; ++b) dit8(x[b], v1);
#pragma unroll
        for (int b = 0; b < NB; ++b)
#pragma unroll
            for (int m = 0; m < 8; ++m) Z[b * ZS + PH(base + m * q)] = x[b][m];
    }
    __syncthreads();
}
template <int NB> __device__ __forceinline__ void fft_conv(LAS f2* Z, int Nf, int tid, const f2 (&hs)[NB][8]) {
    for (int q = Nf >> 3; q > 1; q >>= 3) {
        __syncthreads();
        const int jp = tid & (q - 1), base = ((tid - jp) << 3) + jp; const float rev = (float)jp / (float)(8 * q);
        const f2 w1 = (f2){__builtin_amdgcn_cosf(rev), -__builtin_amdgcn_sinf(rev)};
        const bool first = (q == (Nf >> 3));
        f2 x[NB][8];
        if (first) {
#pragma unroll
            for (int b = 0; b < NB; ++b) {
#pragma unroll
                for (int m = 0; m < 4; ++m) x[b][m] = Z[b * ZS + PH(base + m * q)];
                dif8z(x[b], w1); }
        } else {
#pragma unroll
            for (int b = 0; b < NB; ++b)
#pragma unroll
                for (int m = 0; m < 8; ++m) x[b][m] = Z[b * ZS + PH(base + m * q)];
#pragma unroll
            for (int b = 0; b < NB; ++b) dif8(x[b], w1);
        }
#pragma unroll
        for (int b = 0; b < NB; ++b)
#pragma unroll
            for (int m = 0; m < 8; ++m) Z[b * ZS + PH(base + m * q)] = x[b][m];
    }
    __syncthreads();
    { const int base = tid << 3; f2 x[NB][8];
#pragma unroll
      for (int b = 0; b < NB; ++b)
#pragma unroll
          for (int m = 0; m < 8; ++m) x[b][m] = Z[b * ZS + PH(base + m)];
#pragma unroll
      for (int b = 0; b < NB; ++b) { dif8(x[b], (f2){1.f, 0.f});
#pragma unroll
          for (int m = 0; m < 8; ++m) x[b][m] = cmul(x[b][m], hs[b][m]);
          dit8(x[b], (f2){1.f, 0.f}); }
#pragma unroll
      for (int b = 0; b < NB; ++b)
#pragma unroll
          for (int m = 0; m < 8; ++m) Z[b * ZS + PH(base + m)] = x[b][m]; }
    for (int q = 8; q <= (Nf >> 3); q <<= 3) {
        __syncthreads();
        const int jp = tid & (q - 1), base = ((tid - jp) << 3) + jp; const float rev = (float)jp / (float)(8 * q);
        const f2 v1 = (f2){__builtin_amdgcn_cosf(rev), __builtin_amdgcn_sinf(rev)};
        f2 x[NB][8];
#pragma unroll
        for (int b = 0; b < NB; ++b)
#pragma unroll
            for (int m = 0; m < 8; ++m) x[b][m] = Z[b * ZS + PH(base + m * q)];
#pragma unroll
        for (int b = 0; b < NB; ++b) dit8(x[b], v1);
#pragma unroll
        for (int b = 0; b < NB; ++b)
#pragma unroll
            for (int m = 0; m < 8; ++m) Z[b * ZS + PH(base + m * q)] = x[b][m];
    }
    __syncthreads();
}
#define C8X(m) ((m) == 0 ? 1.f : (m) == 1 ? 0.92387953251f : (m) == 2 ? 0.70710678119f : (m) == 3 ? 0.38268343237f : (m) == 4 ? 0.f : (m) == 5 ? -0.38268343237f : (m) == 6 ? -0.70710678119f : -0.92387953251f)
#define C8Y(m) ((m) == 0 ? 0.f : (m) == 1 ? 0.38268343237f : (m) == 2 ? 0.70710678119f : (m) == 3 ? 0.92387953251f : (m) == 4 ? 1.f : (m) == 5 ? 0.92387953251f : (m) == 6 ? 0.70710678119f : 0.38268343237f)
template <bool ZHI> __device__ __forceinline__ void dif16(f2 (&lo)[8], f2 (&hi)[8], f2 w0) {
#pragma unroll
    for (int m = 0; m < 8; ++m) { const f2 tw = cmul(w0, (f2){C8X(m), -C8Y(m)}); const f2 a = lo[m];
        if (ZHI) { hi[m] = cmul(a, tw); } else { const f2 b = hi[m]; lo[m] = a + b; hi[m] = cmul(a - b, tw); } }
    const f2 w1 = cmul(w0, w0);
    dif8(lo, w1); dif8(hi, w1);
}
__device__ __forceinline__ void dit16(f2 (&lo)[8], f2 (&hi)[8], f2 v0) {
    const f2 v1 = cmul(v0, v0);
    dit8(lo, v1); dit8(hi, v1);
#pragma unroll
    for (int m = 0; m < 8; ++m) { const f2 tw = cmul(v0, (f2){C8X(m), C8Y(m)}); const f2 a = lo[m], t = cmul(hi[m], tw); lo[m] = a + t; hi[m] = a - t; }
}
__device__ __forceinline__ void fft_conv16(LAS f2* Z, int tid_, const f2* Hs) {
    int tid = tid_;
    asm volatile("" : "+v"(tid));
    LAS f2* Zb = Z + (tid >> 8) * ZS; const int g = tid & 255;
    f2 lo[8], hi[8];
    __syncthreads();
    { const float rev = (float)g * (1.0f / 4096.0f); const f2 w0 = (f2){__builtin_amdgcn_cosf(rev), -__builtin_amdgcn_sinf(rev)};
#pragma unroll
      for (int m = 0; m < 8; ++m) lo[m] = Zb[PH(g + m * 256)];
      dif16<true>(lo, hi, w0);
#pragma unroll
      for (int m = 0; m < 8; ++m) { Zb[PH(g + m * 256)] = lo[m]; Zb[PH(g + (m + 8) * 256)] = hi[m]; } }
    __syncthreads();
    { const int jp = g & 15, base = ((g - jp) << 4) + jp; const float rev = (float)jp * (1.0f / 256.0f); const f2 w0 = (f2){__builtin_amdgcn_cosf(rev), -__builtin_amdgcn_sinf(rev)};
#pragma unroll
      for (int m = 0; m < 8; ++m) { lo[m] = Zb[PH(base + m * 16)]; hi[m] = Zb[PH(base + (m + 8) * 16)]; }
      dif16<false>(lo, hi, w0);
#pragma unroll
      for (int m = 0; m < 8; ++m) { Zb[PH(base + m * 16)] = lo[m]; Zb[PH(base + (m + 8) * 16)] = hi[m]; } }
    __syncthreads();
    f2 hs[16];
#pragma unroll
    for (int q = 0; q < 16; q += 2) { const f4 hv = *(const f4*)(Hs + q); hs[q] = (f2){hv[0], hv[1]}; hs[q + 1] = (f2){hv[2], hv[3]}; }
    { const int base = g << 4;
#pragma unroll
      for (int m = 0; m < 8; ++m) { lo[m] = Zb[PH(base + m)]; hi[m] = Zb[PH(base + m + 8)]; }
      dif16<false>(lo, hi, (f2){1.f, 0.f});
#pragma unroll
      for (int m = 0; m < 8; ++m) { lo[m] = cmul(lo[m], hs[m]); hi[m] = cmul(hi[m], hs[m + 8]); }
      dit16(lo, hi, (f2){1.f, 0.f});
#pragma unroll
      for (int m = 0; m < 8; ++m) { Zb[PH(base + m)] = lo[m]; Zb[PH(base + m + 8)] = hi[m]; } }
    __syncthreads();
    { const int jp = g & 15, base = ((g - jp) << 4) + jp; const float rev = (float)jp * (1.0f / 256.0f); const f2 v0 = (f2){__builtin_amdgcn_cosf(rev), __builtin_amdgcn_sinf(rev)};
#pragma unroll
      for (int m = 0; m < 8; ++m) { lo[m] = Zb[PH(base + m * 16)]; hi[m] = Zb[PH(base + (m + 8) * 16)]; }
      dit16(lo, hi, v0);
#pragma unroll
      for (int m = 0; m < 8; ++m) { Zb[PH(base + m * 16)] = lo[m]; Zb[PH(base + (m + 8) * 16)] = hi[m]; } }
    __syncthreads();
    { const float rev = (float)g * (1.0f / 4096.0f); const f2 v0 = (f2){__builtin_amdgcn_cosf(rev), __builtin_amdgcn_sinf(rev)};
#pragma unroll
      for (int m = 0; m < 8; ++m) { lo[m] = Zb[PH(g + m * 256)]; hi[m] = Zb[PH(g + (m + 8) * 256)]; }
      dit16(lo, hi, v0);
#pragma unroll
      for (int m = 0; m < 8; ++m) Zb[PH(g + m * 256)] = lo[m]; }
    __syncthreads();
}
__device__ __forceinline__ float dot64(const f4 (&hr)[16], LAS const float* w) {
    f4 acc = (f4){0.f, 0.f, 0.f, 0.f};
#pragma unroll
    for (int j = 0; j < 16; ++j) acc += hr[j] * *(LAS const f4*)(w + 4 * j);
    return (acc[0] + acc[1]) + (acc[2] + acc[3]);
}
__device__ __forceinline__ void filt_item(const Frame& F, int it) {
    int tid = F.tid; asm volatile("" : "+v"(tid));
    LAS f2* Z = (LAS f2*)F.lds;
    LAS float* w3s = (LAS float*)(F.lds + 4 * ZS * 8);
    LAS float* wsum = w3s + 1024;
    const bool lat = it < 512;
    const int o = lat ? (it >> 8) : ((it - 512) >> 7), c0 = lat ? (it & 255) * 4 : ((it - 512) & 127) * 8, nch = lat ? 4 : 8;
    const int L = lat ? 2048 : 256, Nf = 2 * L;
    const float* tab = (const float*)(F.ws + WS_H2TAB) + (size_t)(lat ? 256 : 0) * 64;
    const float invLm1 = 1.0f / (float)(L - 1);
    __syncthreads();
    for (int i = tid; i < nch * 128; i += NT) { const int ch = i >> 7, dr = (i >> 6) & 1, j = i & 63; w3s[i] = F.hw3[(size_t)j * 4096 + dr * 2048 + o * 1024 + c0 + ch]; }
#pragma unroll
    for (int q = 0; q < 36; ++q) Z[tid + NT * q] = (f2){0.f, 0.f};
    __syncthreads();
    if (lat) {
        const int lane = tid & 63, wv = tid >> 6, l31 = lane & 31, hh = lane >> 5;
        LAS u16* w3b = (LAS u16*)(wsum + 64);
        LAS float* part = wsum + 64 + 1152;
        for (int i = tid; i < 32 * 72; i += NT) { const int n = i / 72, k = i - 72 * n; w3b[i] = (n < 8 && k < 64) ? f2bf(w3s[n * 64 + k]) : (u16)0; }
        __syncthreads();
        bf8 bw[4];
#pragma unroll
        for (int ks = 0; ks < 4; ++ks) bw[ks] = *(LAS bf8*)(w3b + l31 * 72 + 16 * ks + 8 * hh);
        const int nn = l31 & 7, chn = nn >> 1, drn = nn & 1;
        const float decn = fabsf(F.hdecay[o * 1024 + c0 + chn]);
        float sa = 0.f;
#pragma unroll 1
        for (int rtile = wv; rtile < 64; rtile += 8) {
            f16v acc;
#pragma unroll
            for (int j = 0; j < 16; ++j) acc[j] = 0.f;
            const float* hp = tab + (size_t)(32 * rtile + l31) * 64 + 8 * hh;
#pragma unroll
            for (int ks = 0; ks < 4; ++ks) { const f4 a0 = *(const f4*)(hp + 16 * ks), a1 = *(const f4*)(hp + 16 * ks + 4);
                const u4 pk = (u4){pack2(a0[0], a0[1]), pack2(a0[2], a0[3]), pack2(a1[0], a1[1]), pack2(a1[2], a1[3])};
                acc = MFMA32(__builtin_bit_cast(bf8, pk), bw[ks], acc); }
            if (l31 < 8) {
#pragma unroll
                for (int j = 0; j < 16; ++j) { const int pos = 32 * rtile + (j & 3) + 8 * (j >> 2) + 4 * hh; const float v = acc[j] * (__expf(-(float)pos * invLm1 * decn) + 0.05f);
                    if (drn == 0) { Z[chn * ZS + PH(pos)] = (f2){v, 0.f}; sa += fabsf(v); } else if (pos) { Z[chn * ZS + PH(Nf - pos)] = (f2){v, 0.f}; sa += fabsf(v); } } }
        }
        if (l31 < 8) part[(wv * 2 + hh) * 8 + nn] = sa;
        __syncthreads();
        if (tid < 4) { float tot = 0.f;
#pragma unroll
            for (int w = 0; w < 16; ++w) tot += part[w * 8 + 2 * tid] + part[w * 8 + 2 * tid + 1];
            wsum[tid] = tot; }
        __syncthreads();
#pragma unroll
        for (int ch = 0; ch < 4; ++ch) { const float sc = 1.0f / (wsum[ch] * (float)Nf);
#pragma unroll 1
            for (int pp = 0; pp < 4; ++pp) { const int pos = tid + NT * pp; Z[ch * ZS + PH(pos)].x *= sc; if (pos) Z[ch * ZS + PH(Nf - pos)].x *= sc; } }
        fft_fwd<2>(Z, Nf, tid); fft_fwd<2>(Z + 2 * ZS, Nf, tid);
#pragma unroll
        for (int ch = 0; ch < 4; ++ch) { f2* dst = (f2*)(F.ws + WS_HSL) + (size_t)(o * 1024 + c0 + ch) * 4096 + tid * 8;
#pragma unroll
            for (int q = 0; q < 8; q += 2) { const f2 a = Z[ch * ZS + PH(tid * 8 + q)], b = Z[ch * ZS + PH(tid * 8 + q + 1)]; *(f4*)(dst + q) = (f4){a.x, a.y, b.x, b.y}; } }
    } else {
        const int pos = tid & 255, half = tid >> 8;
        f4 hr[16];
#pragma unroll
        for (int j = 0; j < 16; ++j) hr[j] = *(const f4*)(tab + (size_t)pos * 64 + 4 * j);
        float tf[4], tb[4];
#pragma unroll
        for (int ch = 0; ch < 4; ++ch) { const int cc = 4 * half + ch; const float win = __expf(-(float)pos * invLm1 * fabsf(F.hdecay[o * 1024 + c0 + cc])) + 0.05f;
            tf[ch] = dot64(hr, w3s + cc * 128) * win; tb[ch] = pos ? dot64(hr, w3s + cc * 128 + 64) * win : 0.f;
            const float sa = wave_sum(fabsf(tf[ch]) + fabsf(tb[ch])); if (F.lane == 0) wsum[F.wave * 4 + ch] = sa; }
        __syncthreads();
#pragma unroll
        for (int ch = 0; ch < 4; ++ch) { const int cc = 4 * half + ch; float tot = 0.f;
#pragma unroll
            for (int w = 0; w < 4; ++w) tot += wsum[(4 * half + w) * 4 + ch];
            const float sc = 1.0f / (tot * (float)Nf);
            Z[PH(cc * 512 + pos)] = (f2){tf[ch] * sc, 0.f}; if (pos) Z[PH(cc * 512 + Nf - pos)] = (f2){tb[ch] * sc, 0.f}; }
        fft_fwd<1>(Z, Nf, tid);
        { const int e0 = tid * 8, pch = e0 >> 9, n0 = e0 & 511; f2* dst = (f2*)(F.ws + WS_HSC) + (size_t)(o * 1024 + c0 + pch) * 512 + n0;
#pragma unroll
          for (int q = 0; q < 8; q += 2) { const f2 a = Z[PH(e0 + q)], b = Z[PH(e0 + q + 1)]; *(f4*)(dst + q) = (f4){a.x, a.y, b.x, b.y}; } }
    }
}

__device__ __forceinline__ void load_x0(const Frame& F, int r, int lane, f4 (&x)[8]) {
    if (r < MCTX) { const f4* p = (const f4*)(F.x_prompt + (size_t)r * D);
#pragma unroll
        for (int i = 0; i < 8; ++i) x[i] = p[i * 64 + lane]; }
    else { const int rr = r - MCTX; const f4* p = (const f4*)(F.x_sample + (size_t)rr * D); const int t = rr & 2047; const float gr = (float)(t >> 6), gc = (float)(t & 63);
#pragma unroll
        for (int i = 0; i < 8; ++i) { f4 v = p[i * 64 + lane]; const int col = (i * 64 + lane) * 4, ii = col & 511; const float pos = (i < 4) ? gr : gc;
#pragma unroll
            for (int j = 0; j < 4; ++j) { const float om = __builtin_amdgcn_exp2f(-(float)(ii + j) * (13.287712379549449f / 512.0f)); const float a = pos * om * 0.15915494309189535f;
                v[j] += ((i >> 1) & 1) ? __builtin_amdgcn_cosf(a) : __builtin_amdgcn_sinf(a); }
            x[i] = v; } }
}
__device__ __forceinline__ void adaln_store(const Frame& F, int r, int lane, const f4 (&x)[8], int pre_i, int shift_i, int scale_i) {
    float ss = 0.f;
#pragma unroll
    for (int i = 0; i < 8; ++i) ss += x[i][0] * x[i][0] + x[i][1] * x[i][1] + x[i][2] * x[i][2] + x[i][3] * x[i][3];
    ss = wave_sum(ss);
    const float rs = rsqrtf(ss * (1.0f / D) + RMS_EPS);
    const float* md = (const float*)(F.ws + WS_MOD) + (size_t)modidx(r) * 18432;
    u16* H = (u16*)(F.ws + WS_H) + (size_t)r * D;
#pragma unroll
    for (int i = 0; i < 8; ++i) { const int col = (i * 64 + lane) * 4;
        const f4 g = *(const f4*)(F.npre + pre_i * D + col), sh = *(const f4*)(md + shift_i * D + col), sc = *(const f4*)(md + scale_i * D + col);
        const f4 hv = x[i] * rs * g * (1.0f + sc) + sh;
        u2 w; w.x = pack2(hv[0], hv[1]); w.y = pack2(hv[2], hv[3]); *(u2*)(H + col) = w; }
}
__device__ __forceinline__ void phase_adaln1(const Frame& F) {
    for (int r = blockIdx.x * 8 + F.wave; r < MROWS; r += F.G * 8) { f4 x[8]; load_x0(F, r, F.lane, x); adaln_store(F, r, F.lane, x, 0, 0, 1); }
}
__device__ __forceinline__ void phase_res(const Frame& F, int which) {
    const u16* Y = (const u16*)(F.ws + WS_Y); const u16* Y1 = (const u16*)(F.ws + WS_Y1);
    const int gate_i = which == 0 ? 2 : (which == 1 ? 5 : 8); const float gsc = which == 1 ? 1.0f : 0.5f;
    for (int r = blockIdx.x * 8 + F.wave; r < MROWS; r += F.G * 8) {
        const int lane = F.lane; f4 x[8];
        float* X = F.out + (size_t)r * D;
        if (which == 0) load_x0(F, r, lane, x);
        else {
#pragma unroll
            for (int i = 0; i < 8; ++i) x[i] = *(const f4*)(X + (i * 64 + lane) * 4); }
        f4 y[8]; float ss = 0.f;
#pragma unroll
        for (int i = 0; i < 8; ++i) { { const u2 a = *(const u2*)(Y + (size_t)r * D + (i * 64 + lane) * 4), b = *(const u2*)(Y1 + (size_t)r * D + (i * 64 + lane) * 4); y[i] = (f4){bflo(a.x) + bflo(b.x), bfhi(a.x) + bfhi(b.x), bflo(a.y) + bflo(b.y), bfhi(a.y) + bfhi(b.y)}; } ss += y[i][0] * y[i][0] + y[i][1] * y[i][1] + y[i][2] * y[i][2] + y[i][3] * y[i][3]; }
        ss = wave_sum(ss);
        const float rs = rsqrtf(ss * (1.0f / D) + RMS_EPS) * gsc;
        const float* md = (const float*)(F.ws + WS_MOD) + (size_t)modidx(r) * 18432;
#pragma unroll
        for (int i = 0; i < 8; ++i) { const int col = (i * 64 + lane) * 4;
            const f4 g = *(const f4*)(F.npost + which * D + col), gt = *(const f4*)(md + gate_i * D + col);
            x[i] += gt * (y[i] * rs * g);
            *(f4*)(X + col) = x[i]; }
        if (which == 0) adaln_store(F, r, lane, x, 1, 3, 4);
        else if (which == 1) adaln_store(F, r, lane, x, 2, 6, 7);
    }
}

struct GdnRaw { u2 m[4], l[4], rt[4]; };
__device__ __forceinline__ void gdn_tile_fetch(const u16* PG, int r0, int seq_start, int seq_end, int colbase, int tid, GdnRaw& R) {
    const int c4 = tid & 31, tr = tid >> 5, col = colbase + 4 * c4;
#pragma unroll
    for (int p = 0; p < 4; ++p) { const int r = r0 + tr + 16 * p; const u16* pr = PG + (size_t)r * NGD + col;
        R.m[p] = *(const u2*)pr; R.l[p] = (u2){0u, 0u}; R.rt[p] = (u2){0u, 0u};
        if (r > seq_start) R.l[p] = *(const u2*)(pr - NGD);
        if (r + 1 < seq_end) R.rt[p] = *(const u2*)(pr + NGD); }
}
template <int MODE>
__device__ __forceinline__ void gdn_tile_finish(const GdnRaw& R, const float* cw, int r0, int colbase, LAS float* dstf, LAS unsigned char* dstb, u16* dstg, int tid) {
    const int c4 = tid & 31, tr = tid >> 5, col = colbase + 4 * c4;
    const f4 w0 = *(const f4*)(cw + col), w1 = *(const f4*)(cw + 3072 + col), w2 = *(const f4*)(cw + 6144 + col);
#pragma unroll
    for (int p = 0; p < 4; ++p) { const int i = tr + 16 * p; f4 v; const u2 l = R.l[p], m = R.m[p], rt = R.rt[p];
        v[0] = w0[0] * bflo(l.x) + w1[0] * bflo(m.x) + w2[0] * bflo(rt.x); v[1] = w0[1] * bfhi(l.x) + w1[1] * bfhi(m.x) + w2[1] * bfhi(rt.x);
        v[2] = w0[2] * bflo(l.y) + w1[2] * bflo(m.y) + w2[2] * bflo(rt.y); v[3] = w0[3] * bfhi(l.y) + w1[3] * bfhi(m.y) + w2[3] * bfhi(rt.y);
        v[0] = silu_f(v[0]); v[1] = silu_f(v[1]); v[2] = silu_f(v[2]); v[3] = silu_f(v[3]);
        if (MODE < 2) { float ss = v[0] * v[0] + v[1] * v[1] + v[2] * v[2] + v[3] * v[3];
            ss += __shfl_xor(ss, 1); ss += __shfl_xor(ss, 2); ss += __shfl_xor(ss, 4); ss += __shfl_xor(ss, 8); ss += __shfl_xor(ss, 16);
            v *= rsqrtf(ss + RMS_EPS) * (MODE == 0 ? 0.08838834764831845f : 1.0f);
            const u2 wv = (u2){pack2(v[0], v[1]), pack2(v[2], v[3])};
            *(LAS u2*)(dstb + (i * 136 + 4 * c4) * 2) = wv;
            if (MODE == 0) *(u2*)(dstg + (size_t)(r0 + i) * 1024 + 4 * c4) = wv; }
        if (MODE > 0) *(LAS f4*)(dstf + i * 132 + 4 * c4) = v; }
}
template <int I> struct FwdSub {
    static __device__ __forceinline__ void run(f2 (&x)[64], LAS const float* Ad, LAS const float* sc, LAS const float* src, int rstep) {
        FwdSub<I - 1>::run(x, Ad, sc, src, rstep);
        const float eg = sc[I];
        f2 s0 = *(LAS const f2*)(src + I * rstep) * eg, s1 = (f2){0.f, 0.f};
#pragma unroll
        for (int j4 = 0; j4 < (I + 3) / 4; ++j4) { const f4 a = *(LAS const f4*)(Ad + I * 64 + 4 * j4);
            if (4 * j4 + 0 < I) s0 -= x[4 * j4 + 0] * a[0]; if (4 * j4 + 1 < I) s1 -= x[4 * j4 + 1] * a[1]; if (4 * j4 + 2 < I) s0 -= x[4 * j4 + 2] * a[2]; if (4 * j4 + 3 < I) s1 -= x[4 * j4 + 3] * a[3]; }
        x[I] = s0 + s1;
        asm volatile("" ::: "memory");
    }
};
template <> struct FwdSub<-1> { static __device__ __forceinline__ void run(f2 (&)[64], LAS const float*, LAS const float*, LAS const float*, int) {} };
__device__ __forceinline__ void gdn_prep_item(const Frame& F, int item) {
    int tid = F.tid; asm volatile("" : "+v"(tid));
    const int cb = item >> 3, h = item & 7, r0 = cb * 64;
    int seq_start, seq_end;
    if (r0 < MCTX) { seq_start = r0 & ~255; seq_end = seq_start + 256; } else { seq_start = MCTX + ((r0 - MCTX) & ~2047); seq_end = seq_start + 2048; }
    LAS float* Kt = (LAS float*)F.lds; LAS float* Qt = Kt + 64 * 132; LAS float* G = Qt + 64 * 132; LAS float* P = G + 64 * 65; LAS float* A = P + 64 * 65;
    LAS float* gcs = A + 8704; LAS float* bts = gcs + 128; LAS float* ekd = bts + 128; LAS float* beg = ekd + 128;
    LAS unsigned char* Kb = (LAS unsigned char*)A; LAS unsigned char* Qb = Kb + 17408;
    const u16* PG = (const u16*)(F.ws + WS_PG);
    __syncthreads();
    { GdnRaw Rq, Rk, Rv;
      gdn_tile_fetch(PG, r0, seq_start, seq_end, h * 128, tid, Rq); gdn_tile_fetch(PG, r0, seq_start, seq_end, 1024 + h * 128, tid, Rk); gdn_tile_fetch(PG, r0, seq_start, seq_end, 2048 + h * 128, tid, Rv);
      gdn_tile_finish<0>(Rq, F.g_conv, r0, h * 128, nullptr, Qb, (u16*)(F.ws + WS_QN) + h * 128, tid);
      gdn_tile_finish<1>(Rk, F.g_conv, r0, 1024 + h * 128, Kt, Kb, nullptr, tid);
      gdn_tile_finish<2>(Rv, F.g_conv, r0, 2048 + h * 128, Qt, nullptr, nullptr, tid); }
    { const int i = tid >> 3, seg = tid & 7; const u16* zp = PG + (size_t)(r0 + i) * NGD + 3072 + h * 128 + seg * 16; u16* sp = (u16*)(F.ws + WS_SZ) + (size_t)(r0 + i) * 1024 + h * 128 + seg * 16;
#pragma unroll
      for (int q = 0; q < 2; ++q) { const u4 z = *(const u4*)(zp + 8 * q); u4 w;
          w.x = pack2(silu_f(bflo(z.x)), silu_f(bfhi(z.x))); w.y = pack2(silu_f(bflo(z.y)), silu_f(bfhi(z.y))); w.z = pack2(silu_f(bflo(z.z)), silu_f(bfhi(z.z))); w.w = pack2(silu_f(bflo(z.w)), silu_f(bfhi(z.w)));
          *(u4*)(sp + 8 * q) = w; } }
    if (tid < 128) { const int d = tid >> 6, i = tid & 63, r = d ? r0 + 63 - i : r0 + i;
        const u16* abp = PG + (size_t)r * NGD + 4096 + d * 16;
        const float ad = bf2f(abp[h]) + F.g_dtb[d * 8 + h], ab = bf2f(abp[8 + h]);
        const float sp = ad > 20.f ? ad : log1pf(__expf(ad));
        const float g = -__expf(F.g_alog[d * 8 + h]) * sp, beta = 1.0f / (1.0f + __expf(-ab));
        float cs = g;
#pragma unroll
        for (int o = 1; o < 64; o <<= 1) { const float t = __shfl_up(cs, o); if (i >= o) cs += t; }
        gcs[d * 64 + i] = cs; bts[d * 64 + i] = beta; ekd[d * 64 + i] = __expf(__shfl(cs, 63) - cs); beg[d * 64 + i] = beta * __expf(cs);
        ((float*)(F.ws + WS_GC))[(size_t)(d * NITEM_PREP + item) * 64 + i] = cs; }
    __syncthreads();
    { u16* kdt = (u16*)(F.ws + WS_KN);
#pragma unroll
      for (int p = 0; p < 4; ++p) { const int e = tid + NT * p, d = e >> 10, krow = e & 127, seg = (e >> 7) & 7; float v[8];
          const f4 e0 = *(LAS f4*)(ekd + d * 64 + 8 * seg), e1 = *(LAS f4*)(ekd + d * 64 + 8 * seg + 4);
#pragma unroll
          for (int q = 0; q < 8; ++q) { const int cc = 8 * seg + q, ri = d ? 63 - cc : cc; v[q] = Kt[ri * 132 + krow] * (q < 4 ? e0[q & 3] : e1[q & 3]); }
          *(u4*)(kdt + (size_t)(d * NITEM_PREP + item) * 8192 + krow * 64 + 8 * seg) = (u4){pack2(v[0], v[1]), pack2(v[2], v[3]), pack2(v[4], v[5]), pack2(v[6], v[7])}; } }
    { const int lane = tid & 63, wv = tid >> 6, l31 = lane & 31, hh = lane >> 5, it = (wv >> 1) & 1, jt = wv & 1;
      LAS unsigned char* Ab = (wv < 4) ? Kb : Qb; LAS float* Out = (wv < 4) ? G : P;
      f16v acc;
#pragma unroll
      for (int j = 0; j < 16; ++j) acc[j] = 0.f;
#pragma unroll
      for (int ks = 0; ks < 8; ++ks) { const int ko = 16 * ks + 8 * hh;
          const bf8 af = *(LAS bf8*)(Ab + ((32 * it + l31) * 136 + ko) * 2), bf = *(LAS bf8*)(Kb + ((32 * jt + l31) * 136 + ko) * 2);
          acc = MFMA32(af, bf, acc); }
#pragma unroll
      for (int j = 0; j < 16; ++j) Out[(32 * it + (j & 3) + 8 * (j >> 2) + 4 * hh) * 65 + 32 * jt + l31] = acc[j]; }
    __syncthreads();
    { u16* att = (u16*)(F.ws + WS_ATT);
#pragma unroll
      for (int p = 0; p < 2; ++p) { const int c = tid + NT * p, d = c >> 9, i = (c >> 3) & 63, j0 = (c & 7) * 8, ri = d ? 63 - i : i;
          const float gci = gcs[d * 64 + i], bi = bts[d * 64 + i];
          const f4 g0 = *(LAS f4*)(gcs + d * 64 + j0), g1 = *(LAS f4*)(gcs + d * 64 + j0 + 4);
          float av[8], tv[8];
#pragma unroll
          for (int jj = 0; jj < 8; ++jj) { const int j = j0 + jj, rj = d ? 63 - j : j; const float gcj = jj < 4 ? g0[jj & 3] : g1[jj & 3];
              const float dec = __expf(fminf(gci - gcj, 0.f)); const float pv = P[ri * 65 + rj], gv = G[ri * 65 + rj];
              tv[jj] = (i >= j) ? pv * dec : 0.f; av[jj] = (i > j) ? bi * gv * dec : 0.f; }
          *(LAS f4*)(A + d * 4096 + i * 64 + j0) = (f4){av[0], av[1], av[2], av[3]}; *(LAS f4*)(A + d * 4096 + i * 64 + j0 + 4) = (f4){av[4], av[5], av[6], av[7]};
          *(u4*)(att + (size_t)(d * NITEM_PREP + item) * 4096 + i * 64 + j0) = (u4){pack2(tv[0], tv[1]), pack2(tv[2], tv[3]), pack2(tv[4], tv[5]), pack2(tv[6], tv[7])}; } }
    __syncthreads();
    if (tid < 256) { const int d = tid >> 7, col = (tid & 127) * 2; LAS const float* Ad = A + d * 4096; LAS const float* Vt = Qt;
      f2 x[64];
      LAS const float* src = ((col < 128) ? Vt : Kt) + (col & 127) + (d ? 63 * 132 : 0);
      FwdSub<63>::run(x, Ad, ((col < 128) ? bts : beg) + d * 64, src, d ? -132 : 132);
      if (col < 128) { u16* dst = (u16*)(F.ws + WS_U) + (size_t)(d * NITEM_PREP + item) * 8192 + col * 64;
#pragma unroll
          for (int i = 0; i < 64; i += 8) { *(u4*)(dst + i) = (u4){pack2(x[i].x, x[i + 1].x), pack2(x[i + 2].x, x[i + 3].x), pack2(x[i + 4].x, x[i + 5].x), pack2(x[i + 6].x, x[i + 7].x)};
              *(u4*)(dst + 64 + i) = (u4){pack2(x[i].y, x[i + 1].y), pack2(x[i + 2].y, x[i + 3].y), pack2(x[i + 4].y, x[i + 5].y), pack2(x[i + 6].y, x[i + 7].y)}; } }
      else { unsigned* dst = (unsigned*)((u16*)(F.ws + WS_W) + (size_t)(d * NITEM_PREP + item) * 8192 + (col - 128));
#pragma unroll
          for (int i = 0; i < 64; ++i) dst[i * 64] = pack2(-x[i].x, -x[i].y); } }
}

constexpr int SC_WN = 0, SC_QB = 17408, SC_ST = 34816, SC_AT = 69632, SC_VNT = 78848, SC_VST = 97280, SC_KDT = 115712, SC_GT = 134144;
__device__ __forceinline__ void gdn_chain_item(const Frame& F, int chain) {
    int tid = F.tid; asm volatile("" : "+v"(tid));
    const int lane = tid & 63, wv = tid >> 6, l31 = lane & 31, hh = lane >> 5;
    int c, s;
    if (chain < 64) { c = chain; s = 16 + (c >> 4); } else { c = chain - 64; s = c >> 4; }
    const int h = (c >> 1) & 7, d = c & 1;
    const int L = s < 16 ? 256 : 2048, rowbase = s < 16 ? s * 256 : MCTX + (s - 16) * 2048, nc = L >> 6, cb0 = rowbase >> 6;
    LAS unsigned char* lds = F.lds;
    LAS float* gt = (LAS float*)(lds + SC_GT);
    const u16* Wg = (const u16*)(F.ws + WS_W); const u16* Ug = (const u16*)(F.ws + WS_U); const u16* QN = (const u16*)(F.ws + WS_QN); const u16* KD = (const u16*)(F.ws + WS_KN);
    const u16* ATT = (const u16*)(F.ws + WS_ATT); const float* GC = (const float*)(F.ws + WS_GC);
    u16* OX = (u16*)(F.ws + (d ? WS_OB : WS_OF));
    const int rt = wv >> 2, ct = wv & 3;
    const int kt = wv >> 1, vt0 = (wv & 1) * 2;
    float one = 1.0f; asm volatile("" : "+v"(one));
    u4 pW[2], pQ[2], pK[2], pA; u2 pU[4]; float pg = 0.f, pgl = 0.f;
#define SC_FETCH(n_) do { const int cb_ = d ? cb0 + nc - 1 - (n_) : cb0 + (n_), it_ = cb_ * 8 + h, r0_ = cb_ * 64; const size_t tb_ = (size_t)(d * NITEM_PREP + it_); \
        _Pragma("unroll") for (int p = 0; p < 2; ++p) { const int e = tid + NT * p, row = e >> 4, seg = e & 15, trow = d ? r0_ + 63 - row : r0_ + row; \
            pW[p] = *(const u4*)(Wg + tb_ * 8192 + row * 128 + seg * 8); pQ[p] = *(const u4*)(QN + (size_t)trow * 1024 + h * 128 + seg * 8); \
            pK[p] = *(const u4*)(KD + tb_ * 8192 + (e >> 3) * 64 + (e & 7) * 8); } \
        pA = *(const u4*)(ATT + tb_ * 4096 + (tid >> 3) * 64 + (tid & 7) * 8); \
        _Pragma("unroll") for (int q = 0; q < 4; ++q) pU[q] = *(const u2*)(Ug + tb_ * 8192 + (32 * ct + l31) * 64 + 32 * rt + 8 * q + 4 * hh); \
        pgl = GC[tb_ * 64 + 63]; if (tid < 64) pg = GC[tb_ * 64 + tid]; } while (0)
#define SC_COMMIT() do { \
        _Pragma("unroll") for (int p = 0; p < 2; ++p) { const int e = tid + NT * p, row = e >> 4, seg = e & 15; \
            *(LAS u4*)(lds + SC_WN + (row * 136 + seg * 8) * 2) = pW[p]; *(LAS u4*)(lds + SC_QB + (row * 136 + seg * 8) * 2) = pQ[p]; \
            *(LAS u4*)(lds + SC_KDT + ((e >> 3) * 72 + (e & 7) * 8) * 2) = pK[p]; } \
        *(LAS u4*)(lds + SC_AT + ((tid >> 3) * 72 + (tid & 7) * 8) * 2) = pA; \
        if (tid < 64) gt[tid] = __expf(pg); } while (0)
    f16v accS[2];
#pragma unroll
    for (int t = 0; t < 2; ++t)
#pragma unroll
        for (int j = 0; j < 16; ++j) { const int k = 32 * kt + (j & 3) + 8 * (j >> 2) + 4 * hh, v = 32 * (vt0 + t) + l31;
            accS[t][j] = (s >= 16) ? F.state[((size_t)((s - 16) * 2 + d) * 8 + h) * 16384 + k * 128 + v] : 0.f; }
    __syncthreads();
    SC_FETCH(0);
    for (int n = 0; n < nc; ++n) {
#pragma unroll
        for (int t = 0; t < 2; ++t)
#pragma unroll
            for (int q = 0; q < 4; ++q) { const int v = 32 * (vt0 + t) + l31, k0 = 32 * kt + 8 * q + 4 * hh;
                *(LAS u2*)(lds + SC_ST + (v * 136 + k0) * 2) = (u2){pack2h(accS[t][4 * q] * one, accS[t][4 * q + 1] * one), pack2h(accS[t][4 * q + 2] * one, accS[t][4 * q + 3] * one)}; }
        SC_COMMIT();
        f16v accT, accO;
#pragma unroll
        for (int q = 0; q < 4; ++q) { accT[4 * q] = bflo(pU[q].x); accT[4 * q + 1] = bfhi(pU[q].x); accT[4 * q + 2] = bflo(pU[q].y); accT[4 * q + 3] = bfhi(pU[q].y); }
#pragma unroll
        for (int j = 0; j < 16; ++j) accO[j] = 0.f;
        const float eglast = __expf(pgl);
        const int cb = d ? cb0 + nc - 1 - n : cb0 + n, r0 = cb * 64;
        __syncthreads();
        if (n + 1 < nc) SC_FETCH(n + 1);
#pragma unroll
        for (int ks = 0; ks < 8; ++ks) { const int ko = 16 * ks + 8 * hh;
            const bf8 aw = *(LAS bf8*)(lds + SC_WN + ((32 * rt + l31) * 136 + ko) * 2), aq = *(LAS bf8*)(lds + SC_QB + ((32 * rt + l31) * 136 + ko) * 2);
            const bf8 bs = *(LAS bf8*)(lds + SC_ST + ((32 * ct + l31) * 136 + ko) * 2);
            accT = MFMA32(aw, bs, accT); accO = MFMA32(aq, bs, accO); }
#pragma unroll
        for (int q = 0; q < 4; ++q) { const int c0 = 32 * rt + 8 * q + 4 * hh, v = 32 * ct + l31; const f4 eq = *(LAS f4*)(gt + c0);
            *(LAS u2*)(lds + SC_VNT + (v * 72 + c0) * 2) = (u2){pack2h(accT[4 * q] * one, accT[4 * q + 1] * one), pack2h(accT[4 * q + 2] * one, accT[4 * q + 3] * one)};
            accO[4 * q] *= eq[0]; accO[4 * q + 1] *= eq[1]; accO[4 * q + 2] *= eq[2]; accO[4 * q + 3] *= eq[3]; }
        __syncthreads();
#pragma unroll
        for (int ks = 0; ks < 4; ++ks) { const int ko = 16 * ks + 8 * hh;
            const bf8 aa = *(LAS bf8*)(lds + SC_AT + ((32 * rt + l31) * 72 + ko) * 2), bv = *(LAS bf8*)(lds + SC_VNT + ((32 * ct + l31) * 72 + ko) * 2);
            accO = MFMA32(aa, bv, accO); }
#pragma unroll
        for (int j = 0; j < 16; ++j) { const int i = 32 * rt + (j & 3) + 8 * (j >> 2) + 4 * hh, trow = d ? r0 + 63 - i : r0 + i;
            OX[(size_t)trow * 1024 + h * 128 + 32 * ct + l31] = (u16)(pack2h(accO[j] * one, 0.f) & 0xffffu); }
#pragma unroll
        for (int t = 0; t < 2; ++t)
#pragma unroll
            for (int j = 0; j < 16; ++j) accS[t][j] *= eglast;
#pragma unroll
        for (int ks = 0; ks < 4; ++ks) { const int ko = 16 * ks + 8 * hh;
            const bf8 ak = *(LAS bf8*)(lds + SC_KDT + ((32 * kt + l31) * 72 + ko) * 2);
#pragma unroll
            for (int t = 0; t < 2; ++t) { const bf8 bv = *(LAS bf8*)(lds + SC_VNT + ((32 * (vt0 + t) + l31) * 72 + ko) * 2); accS[t] = MFMA32(ak, bv, accS[t]); } }
        __syncthreads();
    }
    if (s < 16) {
#pragma unroll
        for (int t = 0; t < 2; ++t)
#pragma unroll
            for (int j = 0; j < 16; ++j) { const int k = 32 * kt + (j & 3) + 8 * (j >> 2) + 4 * hh, v = 32 * (vt0 + t) + l31;
                F.out[(size_t)MROWS * D + ((size_t)(s * 2 + d) * 8 + h) * 16384 + k * 128 + v] = accS[t][j]; } }
#undef SC_FETCH
#undef SC_COMMIT
}

__device__ __forceinline__ void hy_load_conv(const u16* PT, const float* cw, int ch, int tb, int tau, int L, float (&pc)[8]) {
    const u16* p = PT + (size_t)ch * MROWS + tb + tau;
    const u4 m = *(const u4*)p; float v[10];
    v[0] = (tau & (L - 1)) ? bf2f(p[-1]) : 0.f; v[9] = ((tau + 8) & (L - 1)) ? bf2f(p[8]) : 0.f;
    v[1] = bflo(m.x); v[2] = bfhi(m.x); v[3] = bflo(m.y); v[4] = bfhi(m.y); v[5] = bflo(m.z); v[6] = bfhi(m.z); v[7] = bflo(m.w); v[8] = bfhi(m.w);
    const float w0 = cw[ch], w1 = cw[3072 + ch], w2 = cw[6144 + ch];
#pragma unroll
    for (int q = 0; q < 8; ++q) pc[q] = w0 * v[q] + w1 * v[q + 1] + w2 * v[q + 2];
}
__device__ __forceinline__ void hyena_item(const Frame& F, int hitem) {
    int tid = F.tid; asm volatile("" : "+v"(tid));
    const bool lat = hitem < 1024;
    const int c0 = 2 * (lat ? (hitem >> 1) : (hitem - 1024)), tb = lat ? MCTX + (hitem & 1) * 4096 : 0, L = lat ? 2048 : 256, Nf = 2 * L;
    LAS f2* Z = (LAS f2*)F.lds; LAS float* Zf = (LAS float*)F.lds;
    const u16* PT = (const u16*)(F.ws + WS_PT);
    const int tau = tid * 8, sq = tau / L, t = tau & (L - 1), zi = PH((sq >> 1) * Nf + t), comp = sq & 1;
    float u[2][8], x1[2][8], x2[2][8];
#pragma unroll
    for (int b = 0; b < 2; ++b) { hy_load_conv(PT, F.hy_conv, c0 + b, tb, tau, L, u[b]); hy_load_conv(PT, F.hy_conv, 1024 + c0 + b, tb, tau, L, x1[b]); hy_load_conv(PT, F.hy_conv, 2048 + c0 + b, tb, tau, L, x2[b]); }
    __syncthreads();
#pragma unroll
    for (int b = 0; b < 2; ++b)
#pragma unroll
        for (int q = 0; q < 8; ++q) Zf[2 * (b * ZS + zi + q) + comp] = u[b][q];
#pragma unroll 1
    for (int o = 0; o < 2; ++o) {
        if (lat) { fft_conv16(Z, tid, (const f2*)(F.ws + WS_HSL) + (size_t)(o * 1024 + c0 + (tid >> 8)) * 4096 + (tid & 255) * 16);
        } else { f2 hreg[2][8];
#pragma unroll
            for (int b = 0; b < 2; ++b) { const f2* Hs = (const f2*)(F.ws + WS_HSC) + (size_t)(o * 1024 + c0 + b) * 512 + ((tid * 8) & 511);
#pragma unroll
                for (int q = 0; q < 8; q += 2) { const f4 hv = *(const f4*)(Hs + q); hreg[b][q] = (f2){hv[0], hv[1]}; hreg[b][q + 1] = (f2){hv[2], hv[3]}; } }
            fft_conv<2>(Z, Nf, tid, hreg); }
        float y[2][8];
#pragma unroll
        for (int b = 0; b < 2; ++b) { const float bias = F.hbias[o * 1024 + c0 + b];
#pragma unroll
            for (int q = 0; q < 8; ++q) y[b][q] = Zf[2 * (b * ZS + zi + q) + comp] + u[b][q] * bias; }
        if (o == 0) {
#pragma unroll
            for (int b = 0; b < 2; ++b)
#pragma unroll
                for (int q = 0; q < 8; ++q) u[b][q] = x1[b][q] * y[b][q];
            __syncthreads();
#pragma unroll
            for (int b = 0; b < 2; ++b)
#pragma unroll
                for (int q = 0; q < 8; ++q) Zf[2 * (b * ZS + zi + q) + comp] = u[b][q];
        } else {
#pragma unroll
            for (int b = 0; b < 2; ++b) { u16* zo = (u16*)(F.ws + WS_ZHT) + (size_t)(c0 + b) * MROWS + tb + tau;
                *(u4*)zo = (u4){pack2(x2[b][0] * y[b][0], x2[b][1] * y[b][1]), pack2(x2[b][2] * y[b][2], x2[b][3] * y[b][3]), pack2(x2[b][4] * y[b][4], x2[b][5] * y[b][5]), pack2(x2[b][6] * y[b][6], x2[b][7] * y[b][7])}; }
        }
    }
}

__device__ __forceinline__ int rot24(int t, int s) { const int x = t + s; return x >= 24 ? x - 24 : x; }
__device__ __forceinline__ void hy_out_item(const Frame& F, int tile) {
    int tid = F.tid; asm volatile("" : "+v"(tid)); const int t0 = tile * 24;
    LAS float* T = (LAS float*)F.lds;
    LAS float* red = T + 1024 * 25;
    LAS float* rsv = red + 384;
    const u16* ZHT = (const u16*)(F.ws + WS_ZHT);
    __syncthreads();
#pragma unroll 3
    for (int p = 0; p < 6; ++p) { const int e = tid + NT * p, c = e / 3, q = e - 3 * c, sh = (c >> 3) % 24; const u4 v = *(const u4*)(ZHT + (size_t)c * MROWS + t0 + 8 * q); LAS float* tp = T + c * 25;
        const float f[8] = {bflo(v.x), bfhi(v.x), bflo(v.y), bfhi(v.y), bflo(v.z), bfhi(v.z), bflo(v.w), bfhi(v.w)};
#pragma unroll
        for (int jj = 0; jj < 8; ++jj) tp[rot24(8 * q + jj, sh)] = f[jj]; }
    __syncthreads();
    if (tid < 384) { const int t = tid % 24, cg_ = tid / 24; float s = 0.f;
      for (int k8 = 0; k8 < 8; ++k8) { const int c8 = cg_ * 8 + k8, col = rot24(t, c8 % 24);
#pragma unroll
          for (int k = 0; k < 8; ++k) { const float v = T[(8 * c8 + k) * 25 + col]; s += v * v; } }
      red[cg_ * 24 + t] = s; }
    __syncthreads();
    if (tid < 24) { float s = 0.f;
#pragma unroll
        for (int g = 0; g < 16; ++g) s += red[g * 24 + tid];
        rsv[tid] = rsqrtf(s * (1.0f / 1024.0f) + RMS_EPS); }
    __syncthreads();
    u16* YM = (u16*)(F.ws + WS_H);
#pragma unroll 2
    for (int p = 0; p < 6; ++p) { const int e = tid + NT * p, t = e >> 7, c8 = e & 127, col = rot24(t, c8 % 24); const float rs = rsv[t]; float v[8];
#pragma unroll
        for (int k = 0; k < 8; ++k) v[k] = T[(8 * c8 + k) * 25 + col] * rs * F.hnorm[8 * c8 + k];
        *(u4*)(YM + (size_t)(t0 + t) * D + 8 * c8) = (u4){pack2(v[0], v[1]), pack2(v[2], v[3]), pack2(v[4], v[5]), pack2(v[6], v[7])}; }
}
__device__ __forceinline__ void gdn_out_rows(const Frame& F) {
    const u16* OF = (const u16*)(F.ws + WS_OF); const u16* OB = (const u16*)(F.ws + WS_OB); const u16* SZ = (const u16*)(F.ws + WS_SZ); u16* YM = (u16*)(F.ws + WS_H);
    const int lane = F.lane, col = (lane >> 3) * 128 + (lane & 7) * 16;
    for (int r = blockIdx.x * 8 + F.wave; r < MROWS; r += F.G * 8) {
        float o[16]; float ss = 0.f;
#pragma unroll
        for (int q = 0; q < 2; ++q) { const u4 a = *(const u4*)(OF + (size_t)r * 1024 + col + 8 * q), b = *(const u4*)(OB + (size_t)r * 1024 + col + 8 * q);
            o[8 * q + 0] = bflo(a.x) + bflo(b.x); o[8 * q + 1] = bfhi(a.x) + bfhi(b.x); o[8 * q + 2] = bflo(a.y) + bflo(b.y); o[8 * q + 3] = bfhi(a.y) + bfhi(b.y);
            o[8 * q + 4] = bflo(a.z) + bflo(b.z); o[8 * q + 5] = bfhi(a.z) + bfhi(b.z); o[8 * q + 6] = bflo(a.w) + bflo(b.w); o[8 * q + 7] = bfhi(a.w) + bfhi(b.w); }
#pragma unroll
        for (int k = 0; k < 16; ++k) ss += o[k] * o[k];
        ss += __shfl_xor(ss, 1); ss += __shfl_xor(ss, 2); ss += __shfl_xor(ss, 4);
        const float rs = rsqrtf(ss * (1.0f / 128.0f) + RMS_EPS);
#pragma unroll
        for (int q = 0; q < 2; ++q) { const u4 z = *(const u4*)(SZ + (size_t)r * 1024 + col + 8 * q); const int cc = (lane & 7) * 16 + 8 * q; float v[8];
            const float zz[8] = {bflo(z.x), bfhi(z.x), bflo(z.y), bfhi(z.y), bflo(z.z), bfhi(z.z), bflo(z.w), bfhi(z.w)};
#pragma unroll
            for (int k = 0; k < 8; ++k) v[k] = o[8 * q + k] * rs * F.g_onorm[cc + k] * zz[k];
            *(u4*)(YM + (size_t)r * D + 1024 + col + 8 * q) = (u4){pack2(v[0], v[1]), pack2(v[2], v[3]), pack2(v[4], v[5]), pack2(v[6], v[7])}; }
    }
}


#define XB_TMO      128
#define XB_XCNT(j)  (256  + 64 * (j))
#define XB_XSUB(j)  (1280 + 64 * (j))
#define XB_XGEN(j)  (2304 + 64 * (j))
#define XB_TOP      3328
#define XB_TOPGEN   3392
#define XCD_BAR_WORDS 3456
#define XB_SPIN_CAP (1u << 18)
__device__ __forceinline__ unsigned xb_ld(unsigned* p)              { return __hip_atomic_load(p, __ATOMIC_RELAXED, __HIP_MEMORY_SCOPE_AGENT); }
__device__ __forceinline__ unsigned xb_add(unsigned* p, unsigned v) { return __hip_atomic_fetch_add(p, v, __ATOMIC_RELAXED, __HIP_MEMORY_SCOPE_AGENT); }
__device__ __forceinline__ unsigned xb_xcc_id() { return (unsigned)__builtin_amdgcn_s_getreg((3 << 11) | 20) & 0xFu; }
#define XB_SPIN(cond, bar) do { unsigned _sp = 0; while (cond) { __builtin_amdgcn_s_sleep(1); \
    if ((++_sp & 255u) == 0u) { if (xb_ld(&(bar)[XB_TMO])) break; if (_sp > XB_SPIN_CAP) { atomicAdd(&(bar)[XB_TMO], 1u); break; } } } } while (0)
struct XcdBarrier { unsigned* bar; unsigned x; volatile LAS unsigned* st; };
__device__ __forceinline__ XcdBarrier xcd_barrier_post(unsigned* bar, volatile LAS unsigned* st) {
    XcdBarrier b; b.bar = bar; b.x = xb_xcc_id(); b.st = st;
    if (threadIdx.x == 0) (void)xb_add(&bar[XB_XCNT(b.x)], 1u);
    return b;
}
__device__ __forceinline__ void xcd_barrier_complete(unsigned* bar, unsigned x, unsigned& nloc, unsigned& nx) {
    const unsigned G = gridDim.x * gridDim.y * gridDim.z;
    unsigned sum, cnt, mine, sp = 0u;
    for (;;) {
        sum = 0u; cnt = 0u; mine = 0u;
#pragma unroll
        for (unsigned j = 0; j < 16; ++j) { const unsigned c = xb_ld(&bar[XB_XCNT(j)]); sum += c; cnt += (c > 0u) ? 1u : 0u; mine = (j == x) ? c : mine; }
        if (sum == G) break;
        __builtin_amdgcn_s_sleep(1);
        if ((++sp & 255u) == 0u) { if (xb_ld(&bar[XB_TMO])) break; if (sp > XB_SPIN_CAP) { atomicAdd(&bar[XB_TMO], 1u); break; } }
    }
    nloc = mine > 0u ? mine : 1u; nx = cnt > 0u ? cnt : 1u;
}
__device__ __forceinline__ void xcd_barrier(const XcdBarrier& b) {
    asm volatile("s_waitcnt vmcnt(0)" ::: "memory");
    __syncthreads();
    if (threadIdx.x == 0) {
        unsigned* bar = b.bar;
        __builtin_amdgcn_s_waitcnt(0);
        unsigned nloc = b.st[0], nx = b.st[1];
        if (nloc == 0u) { xcd_barrier_complete(bar, b.x, nloc, nx); b.st[0] = nloc; b.st[1] = nx; }
        const unsigned old = xb_add(&bar[XB_XSUB(b.x)], 1u);
        const unsigned gen = old / nloc;
        if (old + 1u == (gen + 1u) * nloc) {
            __builtin_amdgcn_fence(__ATOMIC_RELEASE, "agent");
            asm volatile("s_waitcnt vmcnt(0)" ::: "memory");
            const unsigned og = xb_add(&bar[XB_TOP], 1u);
            const unsigned tg = og / nx;
            if (og + 1u == (tg + 1u) * nx) xb_add(&bar[XB_TOPGEN], 1u);
            else XB_SPIN(xb_ld(&bar[XB_TOPGEN]) == tg, bar);
            __builtin_amdgcn_fence(__ATOMIC_ACQUIRE, "agent");
            xb_add(&bar[XB_XGEN(b.x)], 1u);
            asm volatile("s_waitcnt vmcnt(0)" ::: "memory");
        } else {
            XB_SPIN(xb_ld(&bar[XB_XGEN(b.x)]) == gen, bar);
            __builtin_amdgcn_fence(__ATOMIC_ACQUIRE, "agent");
            asm volatile("s_waitcnt vmcnt(0)" ::: "memory");
        }
    }
    __syncthreads();
}

constexpr int N_PHASES = 14;
#ifndef ONE_LAUNCH
#define ONE_LAUNCH 0
#endif
__global__ void __launch_bounds__(NT, 2) fwd_kernel(Args args) {
    extern __shared__ __attribute__((aligned(16))) unsigned char lds_raw[];
    cg::grid_group grid = cg::this_grid();
    Frame F;
    F.x_prompt = args.in[0]; F.x_sample = args.in[1]; F.state = args.in[2]; F.cvec = args.in[3]; F.cctx = args.in[4]; F.ada_w = args.in[5]; F.ada_b = args.in[6]; F.npre = args.in[7]; F.npost = args.in[8];
    F.wg = args.in[9]; F.wu = args.in[10]; F.wd = args.in[11]; F.w_in = args.in[12]; F.w_out = args.in[13]; F.hy_conv = args.in[14]; F.hw1 = args.in[15]; F.hb1 = args.in[16]; F.hw2 = args.in[17]; F.hb2 = args.in[18];
    F.hw3 = args.in[19]; F.hdecay = args.in[20]; F.hbias = args.in[21]; F.hnorm = args.in[22]; F.g_conv = args.in[23]; F.g_alog = args.in[24]; F.g_dtb = args.in[25]; F.g_onorm = args.in[26];
    F.out = args.out; F.ws = args.ws; F.lds = (LAS unsigned char*)lds_raw;
    F.tid = threadIdx.x; F.lane = F.tid & 63; F.wave = __builtin_amdgcn_readfirstlane(F.tid >> 6); F.G = gridDim.x;
    const int lo = args.ph_lo, hi = args.ph_hi;
    unsigned* ctl = (unsigned*)(F.ws + WS_CTL);
    LAS int* qslot = (LAS int*)(F.lds + LDS_BYTES - 16);
    const pg8::bf16_t* Hb = (const pg8::bf16_t*)(F.ws + WS_H);
#define IN(k) (lo <= (k) && (k) < hi)
    volatile LAS unsigned* bst = (volatile LAS unsigned*)(F.lds + LDS_BYTES - 32);
    if (F.tid < 2) bst[F.tid] = 0u;
    __syncthreads();
    const XcdBarrier xbar = xcd_barrier_post((unsigned*)(F.ws + WS_BAR), bst);
    if (hi > 1000) grid.sync();
#define SEAM(k) do { if (IN(k) && IN((k) + 1)) xcd_barrier(xbar); } while (0)

    if (IN(0)) { if (blockIdx.x == 0 && F.tid == 0) { ctl[0] = 0u; ctl[1] = 0u; }
        mod_gemv(F); filt_h2(F); conv_inout(F); conv_ffn(F, 0); }
    SEAM(0);
    if (IN(1)) { phase_adaln1(F);
        if (F.G == 256) { if (blockIdx.x < 176) filt_item(F, 336 + (int)blockIdx.x); else if (blockIdx.x < 240) filt_item(F, 704 + (int)blockIdx.x - 176); }
        else for (int it = 336 + blockIdx.x; it < 768; it += F.G) filt_item(F, it); }
    SEAM(1);
    if (IN(2)) { pg8::Gemm g{D, D}; pg8::ZOrder S; S.init(Hb, F.ws + WS_FFGU, MROWS, 2 * FF, nullptr, nullptr, 0, 0, F.G, (int)blockIdx.x);
        pg8::EpiSwiglu E{(pg8::bf16_t*)(F.ws + WS_ACT), FF}; pg8::gemm_phase<pg8::EpiSwiglu, pg8::ZOrder>(F.lds, g, S, E, nullptr);
        if (F.G == 256) { if (blockIdx.x >= 64) { filt_item(F, (int)blockIdx.x - 64); filt_item(F, 512 + (int)blockIdx.x - 64); } } else for (int it = blockIdx.x; it < 192; it += F.G) filt_item(F, it); }
    SEAM(2);
    if (IN(3)) { pg8::Gemm g{FF / 2, FF}; pg8::ZOrder S; S.init(F.ws + WS_ACT, F.ws + WS_FFD, MROWS, D, F.ws + WS_ACT + FF, F.ws + WS_FFD + FF, MROWS, D, F.G, (int)blockIdx.x);
        pg8::EpiBf16<0> E{(pg8::bf16_t*)(F.ws + WS_Y), D, nullptr, 0, 0, (pg8::bf16_t*)(F.ws + WS_Y1), D}; pg8::gemm_phase<pg8::EpiBf16<0>, pg8::ZOrder>(F.lds, g, S, E, nullptr); }
    SEAM(3);
    if (IN(4)) phase_res(F, 0);
    SEAM(4);
    if (IN(5)) { pg8::Gemm g{D, D}; pg8::ZOrder S; S.init(F.ws + WS_WIN, Hb, NHY, MROWS, Hb, F.ws + WS_WIN + (size_t)NHY * D * 2, MROWS, NGD, F.G, (int)blockIdx.x);
        pg8::EpiBf16<0> E{(pg8::bf16_t*)(F.ws + WS_PT), MROWS, nullptr, 0, 0, (pg8::bf16_t*)(F.ws + WS_PG), NGD}; pg8::gemm_phase<pg8::EpiBf16<0>, pg8::ZOrder>(F.lds, g, S, E, nullptr);
        if (F.G == 256) { if (blockIdx.x >= 112) filt_item(F, 192 + (int)blockIdx.x - 112); } else for (int it = 192 + blockIdx.x; it < 336; it += F.G) filt_item(F, it); }
    SEAM(5);
    if (IN(6)) { for (int it = blockIdx.x; it < NITEM_PREP; it += F.G) gdn_prep_item(F, it); }
    SEAM(6);
    if (IN(7)) {
        for (;;) { __syncthreads(); if (F.tid == 0) *qslot = (int)atomicAdd(ctl, 1u); __syncthreads(); const int it = *qslot;
            if (it >= 320 + 1536) break;
            if (it < 320) gdn_chain_item(F, it); else hyena_item(F, it - 320); }
    }
    SEAM(7);
    if (IN(8)) { __syncthreads(); for (int it = blockIdx.x; it < MROWS / 24; it += F.G) hy_out_item(F, it); gdn_out_rows(F); }
    SEAM(8);
    if (IN(9)) { pg8::Gemm g{D / 2, D}; pg8::ZOrder S; S.init(Hb, F.ws + WS_WOUT, MROWS, D, F.ws + WS_H + D, F.ws + WS_WOUT + D, MROWS, D, F.G, (int)blockIdx.x);
        pg8::EpiBf16<0> E{(pg8::bf16_t*)(F.ws + WS_Y), D, nullptr, 0, 0, (pg8::bf16_t*)(F.ws + WS_Y1), D}; pg8::gemm_phase<pg8::EpiBf16<0>, pg8::ZOrder>(F.lds, g, S, E, nullptr); }
    SEAM(9);
    if (IN(10)) { phase_res(F, 1); __syncthreads(); conv_ffn(F, 1); }
    SEAM(10);
    if (IN(11)) { pg8::Gemm g{D, D}; pg8::ZOrder S; S.init(Hb, F.ws + WS_FFGU, MROWS, 2 * FF, nullptr, nullptr, 0, 0, F.G, (int)blockIdx.x);
        pg8::EpiSwiglu E{(pg8::bf16_t*)(F.ws + WS_ACT), FF}; pg8::gemm_phase<pg8::EpiSwiglu, pg8::ZOrder>(F.lds, g, S, E, nullptr); }
    SEAM(11);
    if (IN(12)) { pg8::Gemm g{FF / 2, FF}; pg8::ZOrder S; S.init(F.ws + WS_ACT, F.ws + WS_FFD, MROWS, D, F.ws + WS_ACT + FF, F.ws + WS_FFD + FF, MROWS, D, F.G, (int)blockIdx.x);
        pg8::EpiBf16<0> E{(pg8::bf16_t*)(F.ws + WS_Y), D, nullptr, 0, 0, (pg8::bf16_t*)(F.ws + WS_Y1), D}; pg8::gemm_phase<pg8::EpiBf16<0>, pg8::ZOrder>(F.lds, g, S, E, nullptr); }
    SEAM(12);
    if (IN(13)) phase_res(F, 2);
#undef IN
#undef SEAM
}

extern "C" void kernel_launch(void* const* d_in, const int* in_sizes, int n_in, void* d_out, int out_size, void* d_ws, size_t ws_size, hipStream_t stream) {
    static int grid = 0;
    if (grid == 0) {
        int dev = 0, cus = 0, per_cu = 0;
        if (n_in != 27 || ws_size < WS_END) { fprintf(stderr, "kernel_launch: need 27 inputs and %zu bytes of workspace (got %d, %zu)\n", (size_t)WS_END, n_in, ws_size); grid = -1; return; }
        hipGetDevice(&dev); hipDeviceGetAttribute(&cus, hipDeviceAttributeMultiprocessorCount, dev);
        if (hipFuncSetAttribute((const void*)fwd_kernel, hipFuncAttributeMaxDynamicSharedMemorySize, LDS_BYTES) != hipSuccess) { fprintf(stderr, "kernel_launch: hipFuncSetAttribute failed\n"); grid = -1; return; }
        if (hipOccupancyMaxActiveBlocksPerMultiprocessor(&per_cu, (const void*)fwd_kernel, NT, LDS_BYTES) != hipSuccess || per_cu < 1) { fprintf(stderr, "kernel_launch: occupancy query says %d\n", per_cu); per_cu = 1; }
        (void)hipGetLastError();
        grid = cus * 1;
        fprintf(stderr, "kernel_launch: grid %d (per_cu %d), ws %zu need %zu\n", grid, per_cu, ws_size, (size_t)WS_END);
    }
    if (grid < 0) return;
    (void)hipMemsetAsync((unsigned char*)d_ws + WS_BAR, 0, 16384, stream);
    Args a{};
    for (int i = 0; i < 27; ++i) a.in[i] = (const float*)d_in[i];
    a.out = (float*)d_out; a.ws = (unsigned char*)d_ws;
#if ONE_LAUNCH
    a.ph_lo = 0; a.ph_hi = N_PHASES;
    { void* kargs[] = {&a}; hipError_t e = hipLaunchCooperativeKernel((const void*)fwd_kernel, dim3(grid), dim3(NT), kargs, LDS_BYTES, stream);
      if (e != hipSuccess) fprintf(stderr, "cooperative launch failed: %s\n", hipGetErrorString(e)); }
#else
    for (int p = 0; p < N_PHASES; ++p) { a.ph_lo = p; a.ph_hi = p + 1; void* kargs[] = {&a};
        hipError_t e = hipLaunchCooperativeKernel((const void*)fwd_kernel, dim3(grid), dim3(NT), kargs, LDS_BYTES, stream);
        if (e != hipSuccess) { fprintf(stderr, "launch %d failed: %s\n", p, hipGetErrorString(e)); break; } }
#endif
}
```

```cpp
#define ONE_LAUNCH 1
#include <hip/hip_runtime.h>
namespace pg8 {
#define PG8_LAS __attribute__((address_space(3)))
typedef unsigned short bf16_t;
typedef short bf16x8 __attribute__((ext_vector_type(8)));
typedef float f32x4 __attribute__((ext_vector_type(4)));
typedef unsigned u32x4 __attribute__((ext_vector_type(4)));
constexpr int BM = 256, BK = 64, HALF = 128, HTB = HALF * BK * 2  , STAGE_BYTES = 8 * HTB, NXCD = 8, WGM = 8;

__host__ __device__ __forceinline__ int lds_byte(int r, int c) { const int st = (r >> 4) * 2 + (c >> 5), rr = r & 15, cc = c & 31, ob = rr * 64 + cc * 2; return st * 1024 + (ob ^ (((ob >> 9) & 1) << 5)); }
__host__ __device__ __forceinline__ void stage_rc(int b, int& R, int& C) { const int st = b / 1024, sb = b % 1024, swz = sb ^ (((sb >> 9) & 1) << 5); R = (st >> 1) * 16 + swz / 64; C = (st & 1) * 32 + (swz % 64) / 2; }
__host__ __device__ __forceinline__ int perm32(int rho) { const int n = rho >> 4, i = rho & 15; return 8 * (i >> 2) + 4 * n + (i & 3); }

struct Unit { int pm, pn, z; };
struct Gemm { int K, ld; };

struct StaticOrder {
    int nM, nN, nwg, G, c;
    __host__ __device__ void init(int M, int N, int G_, int c_) { nM = M / BM; nN = N / BM; nwg = nM * nN; G = G_; c = c_; }
    __host__ __device__ bool next(int i, Unit& u) const {
        const long L = (long)i * G + c; if (L >= nwg) return false;
        int wgid = (int)L; { const int q = nwg / NXCD, r = nwg % NXCD, xcd = wgid % NXCD, off = wgid / NXCD; wgid = (xcd < r ? xcd * (q + 1) : r * (q + 1) + (xcd - r) * q) + off; }
        const int nig = WGM * nN, gid = wgid / nig, fm = gid * WGM, gsz = (nM - fm) < WGM ? (nM - fm) : WGM;
        u.pm = fm + ((wgid % nig) % gsz); u.pn = (wgid % nig) / gsz; u.z = 0; return true;
    }
    __device__ __forceinline__ void a_ready(const Unit&) const {}
    __device__ __forceinline__ void done(const Unit&) const {}
};
struct ZOrder {
    const char* A0; const char* B0; const char* A1; const char* B1; int nM0, nN0, nM1, nN1, nwg0, nwg, G, c;
    __device__ void init(const void* a0, const void* b0, int M0, int N0, const void* a1, const void* b1, int M1, int N1, int G_, int c_) {
        A0 = (const char*)a0; B0 = (const char*)b0; A1 = (const char*)a1; B1 = (const char*)b1; nM0 = M0 / BM; nN0 = N0 / BM; nM1 = M1 / BM; nN1 = N1 / BM; nwg0 = nM0 * nN0; nwg = nwg0 + nM1 * nN1; G = G_; c = c_; }
    __device__ bool next(int i, Unit& u) const {
        const long L = (long)i * G + c; if (L >= nwg) return false;
        const int z = L >= nwg0 ? 1 : 0; int wgid = (int)L - (z ? nwg0 : 0); const int nM = z ? nM1 : nM0, nN = z ? nN1 : nN0, nw = nM * nN;
        { const int q = nw / NXCD, r = nw % NXCD, xcd = wgid % NXCD, off = wgid / NXCD; wgid = (xcd < r ? xcd * (q + 1) : r * (q + 1) + (xcd - r) * q) + off; }
        const int nig = WGM * nN, gid = wgid / nig, fm = gid * WGM, gsz = (nM - fm) < WGM ? (nM - fm) : WGM;
        u.pm = fm + ((wgid % nig) % gsz); u.pn = (wgid % nig) / gsz; u.z = z; return true;
    }
    __device__ __forceinline__ void ptrs(const Unit& u, size_t tstep, const char*& a, const char*& b) const { a = (u.z ? A1 : A0) + (size_t)u.pm * tstep; b = (u.z ? B1 : B0) + (size_t)u.pn * tstep; }
    __device__ __forceinline__ void a_ready(const Unit&) const {}
    __device__ __forceinline__ void done(const Unit&) const {}
};
struct CountedOrder : StaticOrder {
    const unsigned* ready; unsigned need; unsigned* tmo;
    __device__ __forceinline__ void a_ready(const Unit& u) const {
        if (threadIdx.x < 64) {
            const unsigned long long t0 = __builtin_amdgcn_s_memrealtime(); unsigned polls = 0;
            while ((unsigned)__builtin_amdgcn_readfirstlane(__hip_atomic_load(ready + 64 * u.pm, __ATOMIC_RELAXED, __HIP_MEMORY_SCOPE_AGENT)) < need) {
                if ((++polls & 255u) == 0u && __builtin_amdgcn_readfirstlane(__hip_atomic_load(tmo, __ATOMIC_RELAXED, __HIP_MEMORY_SCOPE_AGENT)) != 0u) break;
                if (__builtin_amdgcn_s_memrealtime() - t0 > 2000000ull) {
                    if (threadIdx.x == 0) { unsigned expect = 0u; __hip_atomic_compare_exchange_strong(tmo + 1, &expect, 0x600u | (unsigned)(u.pm & 0xff), __ATOMIC_RELAXED, __ATOMIC_RELAXED, __HIP_MEMORY_SCOPE_AGENT); __hip_atomic_store(tmo, 1u, __ATOMIC_RELAXED, __HIP_MEMORY_SCOPE_AGENT); }
                    break; }
                __builtin_amdgcn_s_sleep(2); }
            __builtin_amdgcn_fence(__ATOMIC_ACQUIRE, "agent");
            asm volatile("s_waitcnt vmcnt(0)" ::: "memory");
        }
#if !defined(BROKEN_HOOK_NO_BARRIER)
        asm volatile("" ::: "memory"); __builtin_amdgcn_s_barrier(); asm volatile("" ::: "memory");
#endif
    }
};

__device__ __forceinline__ unsigned cvt_pk_bf16(float lo, float hi) { unsigned r; asm volatile("v_cvt_pk_bf16_f32 %0, %1, %2" : "=v"(r) : "v"(lo), "v"(hi)); return r; }
typedef float f32x2 __attribute__((ext_vector_type(2)));
__device__ __forceinline__ f32x2 gelu_pk(f32x2 v) {
    const f32x2 av = __builtin_elementwise_abs(v), d = av * 0.2316418882f + 1.0f;
    f32x2 t; t.x = __builtin_amdgcn_rcpf(d.x); t.y = __builtin_amdgcn_rcpf(d.y);
    f32x2 q = t * 0.5307027145f + (-0.7265760135f); q = q * t + 0.7107068705f; q = q * t + (-0.142248368f); q = q * t + 0.127414796f; q = q * t;
    const f32x2 s = (v * v) * (-0.72134752044f);
    f32x2 e; e.x = __builtin_amdgcn_exp2f(s.x); e.y = __builtin_amdgcn_exp2f(s.y);
    const f32x2 m = v * (q * e), r = v - m;
    f32x2 o; o.x = v.x < 0.f ? m.x : r.x; o.y = v.y < 0.f ? m.y : r.y; return o;
}

struct EpiF32 {
    static constexpr bool PERM = false, AFTER_DRAIN = false;
    float* C; int ldc; const float* bias; float* C1;
    __device__ __forceinline__ void operator()(const f32x4 (&acc)[2][2][4][2], const Unit& u, int wr, int wc, int fr, int fq) const {
        const int row0 = u.pm * BM + wr * 64 + fr, col0 = u.pn * BM + wc * 32 + 4 * fq;
        f32x4 bv[2][2];
#pragma unroll
        for (int bj = 0; bj < 2; ++bj)
#pragma unroll
            for (int n = 0; n < 2; ++n) bv[bj][n] = bias ? *(const f32x4*)(bias + col0 + bj * HALF + n * 16) : (f32x4){0.f, 0.f, 0.f, 0.f};
#pragma unroll
        for (int ai = 0; ai < 2; ++ai)
#pragma unroll
            for (int m = 0; m < 4; ++m) { float* rowp = (u.z ? C1 : C) + (size_t)(row0 + ai * HALF + m * 16) * ldc + col0;
#pragma unroll
                for (int bj = 0; bj < 2; ++bj)
#pragma unroll
                    for (int n = 0; n < 2; ++n) *(f32x4*)(rowp + bj * HALF + n * 16) = acc[ai][bj][m][n] + bv[bj][n]; }
    }
};
template <int ACT  > struct EpiBf16 {
    static constexpr bool PERM = true, AFTER_DRAIN = false;
    bf16_t* O; int ldc; const float* bias; int split_cols; size_t split_stride; bf16_t* O1; int ldc1;
    __device__ __forceinline__ void operator()(const f32x4 (&acc)[2][2][4][2], const Unit& u, int wr, int wc, int fr, int fq) const {
        const int row0 = u.pm * BM + wr * 64 + fr; int colt = u.pn * BM; bf16_t* base = u.z ? O1 : O; const int ldc = u.z ? ldc1 : this->ldc;
        if (split_cols) { const int t = colt / split_cols; base += (size_t)t * split_stride; colt -= t * split_cols; }
        const int col0 = colt + wc * 32 + 8 * fq, bcol0 = u.pn * BM + wc * 32 + 8 * fq;
        f32x4 bv[2][2];
#pragma unroll
        for (int bj = 0; bj < 2; ++bj)
#pragma unroll
            for (int n = 0; n < 2; ++n) bv[bj][n] = bias ? *(const f32x4*)(bias + bcol0 + bj * HALF + 4 * n) : (f32x4){0.f, 0.f, 0.f, 0.f};
#pragma unroll
        for (int ai = 0; ai < 2; ++ai)
#pragma unroll
            for (int m = 0; m < 4; ++m) { bf16_t* rowp = base + (size_t)(row0 + ai * HALF + m * 16) * ldc + col0;
#pragma unroll
                for (int bj = 0; bj < 2; ++bj) { f32x4 v0 = acc[ai][bj][m][0] + bv[bj][0], v1 = acc[ai][bj][m][1] + bv[bj][1];
                    if (ACT == 1) { f32x2 a = gelu_pk((f32x2){v0[0], v0[1]}), b = gelu_pk((f32x2){v0[2], v0[3]}), c = gelu_pk((f32x2){v1[0], v1[1]}), d = gelu_pk((f32x2){v1[2], v1[3]});
                        v0 = (f32x4){a.x, a.y, b.x, b.y}; v1 = (f32x4){c.x, c.y, d.x, d.y}; }
                    if (ACT == 2) {
#pragma unroll
                        for (int j = 0; j < 4; ++j) { v0[j] = 0.5f * v0[j] * (1.0f + erff(v0[j] * 0.70710678f)); v1[j] = 0.5f * v1[j] * (1.0f + erff(v1[j] * 0.70710678f)); } }
                    u32x4 w; w.x = cvt_pk_bf16(v0[0], v0[1]); w.y = cvt_pk_bf16(v0[2], v0[3]); w.z = cvt_pk_bf16(v1[0], v1[1]); w.w = cvt_pk_bf16(v1[2], v1[3]);
                    *(u32x4*)(rowp + bj * HALF) = w; } }
    }
};

struct EpiSwiglu {
    static constexpr bool PERM = true, AFTER_DRAIN = false;
    bf16_t* O; int ldc;
    __device__ __forceinline__ float sg(float g, float u) const { return g * __builtin_amdgcn_rcpf(1.0f + __builtin_amdgcn_exp2f(-1.44269504089f * g)) * u; }
    __device__ __forceinline__ void operator()(const f32x4 (&acc)[2][2][4][2], const Unit& u, int wr, int wc, int fr, int fq) const {
        const int row0 = u.pm * BM + wr * 64 + fr, col0 = u.pn * HALF + wc * 32 + 8 * fq;
#pragma unroll
        for (int ai = 0; ai < 2; ++ai)
#pragma unroll
            for (int m = 0; m < 4; ++m) { bf16_t* rowp = O + (size_t)(row0 + ai * HALF + m * 16) * ldc + col0;
                const f32x4 g0 = acc[ai][0][m][0], g1 = acc[ai][0][m][1], u0 = acc[ai][1][m][0], u1 = acc[ai][1][m][1];
                u32x4 w; w.x = cvt_pk_bf16(sg(g0[0], u0[0]), sg(g0[1], u0[1])); w.y = cvt_pk_bf16(sg(g0[2], u0[2]), sg(g0[3], u0[3]));
                w.z = cvt_pk_bf16(sg(g1[0], u1[0]), sg(g1[1], u1[1])); w.w = cvt_pk_bf16(sg(g1[2], u1[2]), sg(g1[3], u1[3]));
                *(u32x4*)rowp = w; }
    }
};
template <class Epi, class Sched, bool STAMP = false>
__device__ __forceinline__ void gemm_phase(PG8_LAS unsigned char* lds, const Gemm g, const Sched& S, const Epi& E, unsigned long long* stamps) {
    const int tid = threadIdx.x, wid = __builtin_amdgcn_readfirstlane(tid >> 6), lane = tid & 63, wr = wid >> 2, wc = wid & 3, fr = lane & 15, fq = lane >> 4;
    const int K = g.K, nt = K / BK, ld = g.ld;
    int ts_lo = 0, ts_hi = 0, nts = 0; const unsigned long long rt_entry = STAMP ? (unsigned long long)wall_clock64() : 0ull;
#define PG8_STAMP() do { if (STAMP && wid == 0 && nts < 64) { const unsigned long long _c = (unsigned long long)clock64(); \
        ts_lo = (lane == nts) ? (int)(unsigned)_c : ts_lo; ts_hi = (lane == nts) ? (int)(unsigned)(_c >> 32) : ts_hi; ++nts; } } while (0)
    PG8_STAMP();
    unsigned voffA[2], voffB[2];
#pragma unroll
    for (int i = 0; i < 2; ++i) { int R, C; stage_rc(tid * 16 + i * 8192, R, C); const int Rb = Epi::PERM ? ((R & ~31) + perm32(R & 31)) : R;
        voffA[i] = (unsigned)(R * ld + C) * 2u; voffB[i] = (unsigned)(Rb * ld + C) * 2u; }
    const size_t kstep = (size_t)(BK * 2);
    const size_t hstep = (size_t)HALF * ld * 2;
    const size_t tstep = 2 * hstep;
    const unsigned ldsw = (unsigned)wid * 1024u;
    const int aoff = lds_byte(wr * 64 + fr, fq * 8), boff = lds_byte(wc * 32 + fr, fq * 8);
#define PG8_SA(b, h) (((b) * 2 + (h)) * HTB)
#define PG8_SB(b, h) ((4 + (b) * 2 + (h)) * HTB)
#define PG8_STAGE(bufoff, gbase, voff) do { _Pragma("unroll") for (int _i = 0; _i < 2; ++_i) \
        __builtin_amdgcn_global_load_lds((const unsigned*)((const char*)(gbase) + (voff)[_i]), (PG8_LAS unsigned*)(lds + (bufoff) + ldsw + _i * 8192), 16, 0, 0); } while (0)
#define PG8_LDA(dst, b, h) do { _Pragma("unroll") for (int m = 0; m < 4; ++m) _Pragma("unroll") for (int k = 0; k < 2; ++k) dst[m][k] = *(const PG8_LAS bf16x8*)(lds + PG8_SA(b, h) + aoff + m * 2048 + k * 1024); } while (0)
#define PG8_LDB(dst, b, h) do { _Pragma("unroll") for (int n = 0; n < 2; ++n) _Pragma("unroll") for (int k = 0; k < 2; ++k) dst[n][k] = *(const PG8_LAS bf16x8*)(lds + PG8_SB(b, h) + boff + n * 2048 + k * 1024); } while (0)
#define PG8_MMA(ai, bj, At, Bt) do { __builtin_amdgcn_s_setprio(1); _Pragma("unroll") for (int m = 0; m < 4; ++m) _Pragma("unroll") for (int n = 0; n < 2; ++n) _Pragma("unroll") for (int k = 0; k < 2; ++k) \
        acc[ai][bj][m][n] = __builtin_amdgcn_mfma_f32_16x16x32_bf16(Bt[n][k], At[m][k], acc[ai][bj][m][n], 0, 0, 0); __builtin_amdgcn_s_setprio(0); } while (0)
#define PG8_WAIT_V(n) asm volatile("s_waitcnt vmcnt(" #n ")" ::: "memory")
#define PG8_WAIT_L(n) asm volatile("s_waitcnt lgkmcnt(" #n ")" ::: "memory")
#define PG8_BAR __builtin_amdgcn_s_barrier()
#define PG8_SCHED __builtin_amdgcn_sched_barrier(0)
    Unit cur, nxt; int ui = 0;
    if (!S.next(0, cur)) return;
    f32x4 acc[2][2][4][2];
#pragma unroll
    for (int a = 0; a < 2; ++a)
#pragma unroll
        for (int b = 0; b < 2; ++b)
#pragma unroll
            for (int m = 0; m < 4; ++m)
#pragma unroll
                for (int n = 0; n < 2; ++n) acc[a][b][m][n] = (f32x4){0.f, 0.f, 0.f, 0.f};
    bf16x8 At[4][2], B0[2][2], B1[2][2];
    const char* cA; const char* cB; S.ptrs(cur, tstep, cA, cB);
    S.a_ready(cur);
    PG8_STAGE(PG8_SB(0, 0), cB, voffB); PG8_STAGE(PG8_SB(0, 1), cB + hstep, voffB); PG8_STAGE(PG8_SA(0, 0), cA, voffA); PG8_STAGE(PG8_SA(0, 1), cA + hstep, voffA);
    if (wr == 1) PG8_BAR;
    PG8_WAIT_V(2); PG8_BAR;
    PG8_STAGE(PG8_SB(1, 0), cB + kstep, voffB); PG8_STAGE(PG8_SA(1, 0), cA + kstep, voffA); PG8_STAGE(PG8_SB(1, 1), cB + hstep + kstep, voffB);
    PG8_WAIT_V(6); PG8_BAR;
    PG8_STAMP();
    for (;;) {
        const bool has_next = S.next(ui + 1, nxt);
        const char* nA = cA; const char* nB = cB; if (has_next) S.ptrs(nxt, tstep, nA, nB);
        for (int t = 0; t < nt; t += 2) {
            const bool last = (t == nt - 2);
            const char* a1 = cA + (size_t)(t + 1) * kstep;
            const char* a2 = last ? nA : cA + (size_t)(t + 2) * kstep; const char* b2 = last ? nB : cB + (size_t)(t + 2) * kstep;
            const char* a3 = a2 + kstep; const char* b3 = b2 + kstep;
            if (last && has_next) S.a_ready(nxt);
            PG8_LDB(B0, 0, 0); PG8_LDB(B1, 0, 1); PG8_SCHED; PG8_LDA(At, 0, 0); PG8_STAGE(PG8_SA(1, 1), a1 + hstep, voffA);
            PG8_WAIT_V(8); PG8_WAIT_L(0); PG8_BAR; PG8_MMA(0, 0, At, B0); PG8_MMA(0, 1, At, B1); PG8_BAR; PG8_SCHED;
            PG8_LDA(At, 0, 1); PG8_STAGE(PG8_SB(0, 0), b2, voffB); PG8_STAGE(PG8_SB(0, 1), b2 + hstep, voffB); PG8_STAGE(PG8_SA(0, 0), a2, voffA);
            PG8_WAIT_V(8); PG8_WAIT_L(0); PG8_BAR; PG8_MMA(1, 0, At, B0); PG8_MMA(1, 1, At, B1); PG8_BAR; PG8_SCHED;
            PG8_LDB(B0, 1, 0); PG8_LDB(B1, 1, 1); PG8_SCHED; PG8_LDA(At, 1, 0); PG8_STAGE(PG8_SA(0, 1), a2 + hstep, voffA);
            PG8_WAIT_V(8); PG8_WAIT_L(0); PG8_BAR; PG8_MMA(0, 0, At, B0); PG8_MMA(0, 1, At, B1); PG8_BAR; PG8_SCHED;
            PG8_LDA(At, 1, 1); PG8_STAGE(PG8_SB(1, 0), b3, voffB); PG8_STAGE(PG8_SB(1, 1), b3 + hstep, voffB); PG8_STAGE(PG8_SA(1, 0), a3, voffA);
            PG8_WAIT_V(8); PG8_WAIT_L(0); PG8_BAR; PG8_MMA(1, 0, At, B0); PG8_MMA(1, 1, At, B1); PG8_BAR; PG8_SCHED;
        }
        PG8_STAMP();
        if (wr == 0) PG8_BAR;
        if constexpr (!Epi::AFTER_DRAIN) { E(acc, cur, wr, wc, fr, fq); S.done(cur); }
        PG8_STAMP();
        if (!has_next) break;
#pragma unroll
        for (int a = 0; a < 2; ++a)
#pragma unroll
            for (int b = 0; b < 2; ++b)
#pragma unroll
                for (int m = 0; m < 4; ++m)
#pragma unroll
                    for (int n = 0; n < 2; ++n) acc[a][b][m][n] = (f32x4){0.f, 0.f, 0.f, 0.f};
        cur = nxt; cA = nA; cB = nB; ++ui;
        if (wr == 1) PG8_BAR;
    }
    PG8_WAIT_V(0);
    PG8_BAR;
    if constexpr (Epi::AFTER_DRAIN) { E.fused(acc, cur, wr, wc, fr, fq, lds, wid, lane); S.done(cur); }
    PG8_STAMP();
    if (STAMP && wid == 0) { stamps[lane] = lane < nts ? (((unsigned long long)(unsigned)ts_hi << 32) | (unsigned)ts_lo) : 0ull;
        if (lane == 62) stamps[62] = rt_entry; if (lane == 63) stamps[63] = (unsigned long long)wall_clock64(); }
#undef PG8_STAMP
#undef PG8_SA
#undef PG8_SB
#undef PG8_STAGE
#undef PG8_LDA
#undef PG8_LDB
#undef PG8_MMA
#undef PG8_WAIT_V
#undef PG8_WAIT_L
#undef PG8_BAR
#undef PG8_SCHED
}
}

#include <hip/hip_cooperative_groups.h>
#include <cstdio>
namespace cg = cooperative_groups;
#define LAS __attribute__((address_space(3)))
typedef float f4 __attribute__((ext_vector_type(4)));
typedef float f2 __attribute__((ext_vector_type(2)));
typedef unsigned u4 __attribute__((ext_vector_type(4)));
typedef unsigned u2 __attribute__((ext_vector_type(2)));
typedef unsigned short u16;
typedef short bf8 __attribute__((ext_vector_type(8)));
typedef float f16v __attribute__((ext_vector_type(16)));
#define MFMA32(a, b, c) __builtin_amdgcn_mfma_f32_32x32x16_bf16((a), (b), (c), 0, 0, 0)

constexpr int D = 2048, FF = 5632, MROWS = 12288, MCTX = 4096;
constexpr int NHY = 3072, NGD = 4352, NWIN = 7200, NWINP = 7424;
constexpr int NT = 512;
constexpr int LDS_BYTES = 163840;
constexpr int NITEM_PREP = 1536;
constexpr float RMS_EPS = 1e-6f;

constexpr size_t al256(size_t x) { return (x + 255) & ~(size_t)255; }
constexpr size_t WS_WIN = 0;
constexpr size_t WS_WOUT = WS_WIN + (size_t)NWINP * D * 2;
constexpr size_t WS_FFGU = WS_WOUT + (size_t)D * D * 2;
constexpr size_t WS_FFD = WS_FFGU + (size_t)2 * FF * D * 2;
constexpr size_t WS_FFEND = WS_FFD + (size_t)D * FF * 2;
constexpr size_t WS_H = WS_FFEND;
constexpr size_t WS_MOD = WS_H + (size_t)MROWS * D * 2;
constexpr size_t WS_CTL = WS_MOD + al256((size_t)5 * 18432 * 4);
constexpr size_t WS_BAR = WS_CTL + 256;
constexpr size_t WS_H2TAB = WS_BAR + 16384;
constexpr size_t WS_HSC = WS_H2TAB + (size_t)2304 * 64 * 4;
constexpr size_t WS_HSL = WS_HSC + (size_t)2 * 1024 * 512 * 8;
constexpr size_t WS_D = WS_HSL + (size_t)2 * 1024 * 4096 * 8;
constexpr size_t WS_ACT = WS_D;
constexpr size_t WS_Y = WS_D + (size_t)MROWS * FF * 2;
constexpr size_t WS_Y1 = WS_Y + (size_t)MROWS * D * 4;
constexpr size_t WS_PT = WS_D;
constexpr size_t WS_PG = WS_PT + (size_t)NHY * MROWS * 2;
constexpr size_t WS_QN = WS_PG + (size_t)MROWS * NGD * 2;
constexpr size_t WS_KN = WS_QN + (size_t)MROWS * 1024 * 2;
constexpr size_t WS_W = WS_KN + (size_t)2 * MROWS * 1024 * 2;
constexpr size_t WS_U = WS_W + (size_t)2 * MROWS * 1024 * 2;
constexpr size_t WS_END = WS_U + (size_t)2 * MROWS * 1024 * 2;
constexpr size_t WS_OF = WS_PG;
constexpr size_t WS_OB = WS_OF + (size_t)MROWS * 1024 * 2;
constexpr size_t WS_ZHT = WS_OB + (size_t)MROWS * 1024 * 2;
static_assert(WS_ZHT + (size_t)1024 * MROWS * 4 <= WS_QN, "P7 outputs must fit the PG region");
static_assert(WS_Y1 + (size_t)MROWS * D * 4 <= WS_END, "Y fits");
constexpr size_t WS_SZ = WS_FFGU;
constexpr size_t WS_ATT = WS_SZ + (size_t)MROWS * 1024 * 2;
constexpr size_t WS_GC = WS_ATT + (size_t)2 * NITEM_PREP * 4096 * 2;
static_assert(WS_GC + (size_t)2 * NITEM_PREP * 64 * 4 <= WS_FFEND, "P6 extras fit the FFN weight region");

struct Args { const float* in[27]; float* out; unsigned char* ws; int ph_lo, ph_hi; };

struct Frame {
    const float *x_prompt, *x_sample, *state, *cvec, *cctx, *ada_w, *ada_b, *npre, *npost, *wg, *wu, *wd, *w_in, *w_out;
    const float *hy_conv, *hw1, *hb1, *hw2, *hb2, *hw3, *hdecay, *hbias, *hnorm, *g_conv, *g_alog, *g_dtb, *g_onorm;
    float* out; unsigned char* ws;
    LAS unsigned char* lds;
    int tid, lane, wave, G;
};

__device__ __forceinline__ u16 f2bf(float f) { unsigned u = __float_as_uint(f); u += 0x7FFFu + ((u >> 16) & 1u); return (u16)(u >> 16); }
__device__ __forceinline__ float bf2f(unsigned b) { return __uint_as_float(b << 16); }
__device__ __forceinline__ unsigned pack2(float a, float b) { return (unsigned)f2bf(a) | ((unsigned)f2bf(b) << 16); }
__device__ __forceinline__ float bflo(unsigned w) { return __uint_as_float(w << 16); }
__device__ __forceinline__ float bfhi(unsigned w) { return __uint_as_float(w & 0xffff0000u); }
__device__ __forceinline__ float wave_sum(float v) {
#pragma unroll
    for (int o = 32; o >= 1; o >>= 1) v += __shfl_xor(v, o);
    return v; }
__device__ __forceinline__ float silu_f(float x) { return x * __builtin_amdgcn_rcpf(1.0f + __expf(-x)); }
__device__ __forceinline__ int modidx(int r) { return r < MCTX ? 0 : 1 + ((r - MCTX) >> 11); }

struct CvJob { const float* src; u16* dst; int N, ldd, map, kt, nt; };
__device__ __forceinline__ void conv_load(const Frame& F, const CvJob& j, int slot, int tid) {
    LAS float* T = (LAS float*)F.lds + slot * (64 * 65);
    const int k0 = j.kt * 64, n0 = j.nt * 64;
#pragma unroll
    for (int p = 0; p < 2; ++p) { const int kr = (tid >> 4) + 32 * p, c4 = tid & 15, n = n0 + 4 * c4;
        f4 v = (f4){0.f, 0.f, 0.f, 0.f}; if (n < j.N) v = *(const f4*)(j.src + (size_t)(k0 + kr) * j.N + n);
        T[(4 * c4 + 0) * 65 + kr] = v[0]; T[(4 * c4 + 1) * 65 + kr] = v[1]; T[(4 * c4 + 2) * 65 + kr] = v[2]; T[(4 * c4 + 3) * 65 + kr] = v[3]; }
}
__device__ __forceinline__ void conv_store(const Frame& F, const CvJob& j, int slot, int tid) {
    LAS float* T = (LAS float*)F.lds + slot * (64 * 65);
    const int k0 = j.kt * 64, n0 = j.nt * 64, n = tid >> 3, seg = tid & 7, nn = n0 + n;
    if (nn < j.N) { const int row = j.map == 0 ? nn : ((nn >> 7) * 256 + (j.map - 1) * 128 + (nn & 127));
        u4 w; w.x = pack2(T[n * 65 + 8 * seg + 0], T[n * 65 + 8 * seg + 1]); w.y = pack2(T[n * 65 + 8 * seg + 2], T[n * 65 + 8 * seg + 3]);
        w.z = pack2(T[n * 65 + 8 * seg + 4], T[n * 65 + 8 * seg + 5]); w.w = pack2(T[n * 65 + 8 * seg + 6], T[n * 65 + 8 * seg + 7]);
        *(u4*)(j.dst + (size_t)row * j.ldd + k0 + 8 * seg) = w; }
}
__device__ __forceinline__ bool conv_job(const Frame& F, int which, int f, int t, CvJob& j) {
    if (which == 0) { if (t >= 3 * 2816) return false;
        if (t < 2816) { j.src = F.wg + (size_t)f * D * FF; j.dst = (u16*)(F.ws + WS_FFGU); j.N = FF; j.ldd = D; j.map = 1; j.kt = t / 88; j.nt = t % 88; }
        else if (t < 5632) { const int u = t - 2816; j.src = F.wu + (size_t)f * D * FF; j.dst = (u16*)(F.ws + WS_FFGU); j.N = FF; j.ldd = D; j.map = 2; j.kt = u / 88; j.nt = u % 88; }
        else { const int u = t - 5632; j.src = F.wd + (size_t)f * FF * D; j.dst = (u16*)(F.ws + WS_FFD); j.N = D; j.ldd = FF; j.map = 0; j.kt = u / 32; j.nt = u % 32; }
        return true; }
    if (t >= 32 * 113 + 1024) return false;
    if (t < 32 * 113) { j.src = F.w_in; j.dst = (u16*)(F.ws + WS_WIN); j.N = NWIN; j.ldd = D; j.map = 0; j.kt = t / 113; j.nt = t % 113; }
    else { const int u = t - 32 * 113; j.src = F.w_out; j.dst = (u16*)(F.ws + WS_WOUT); j.N = D; j.ldd = D; j.map = 0; j.kt = u / 32; j.nt = u % 32; }
    return true;
}
__device__ __forceinline__ void conv_run(const Frame& F, int which, int f) {
    int tid = F.tid; asm volatile("" : "+v"(tid));
    const int ntile = which == 0 ? 3 * 2816 : 32 * 113 + 1024;
    for (int t0 = blockIdx.x * 4; t0 < ntile; t0 += F.G * 4) {
        CvJob j0, j1, j2, j3;
        conv_job(F, which, f, min(t0 + 0, ntile - 1), j0); conv_job(F, which, f, min(t0 + 1, ntile - 1), j1); conv_job(F, which, f, min(t0 + 2, ntile - 1), j2); conv_job(F, which, f, min(t0 + 3, ntile - 1), j3);
        const int kr = tid >> 4, c4 = tid & 15;
        f4 v[8];
#define CV_LD(J, o) do { const int n = J.nt * 64 + 4 * c4; const bool ok = n < J.N; const float* sp = J.src + (size_t)(J.kt * 64 + kr) * J.N + (ok ? n : 0); \
            v[o] = *(const f4*)sp; v[o + 1] = *(const f4*)(sp + (size_t)32 * J.N); if (!ok) { v[o] = (f4){0.f, 0.f, 0.f, 0.f}; v[o + 1] = v[o]; } } while (0)
        CV_LD(j0, 0); CV_LD(j1, 2); CV_LD(j2, 4); CV_LD(j3, 6);
#undef CV_LD
        __syncthreads();
#pragma unroll
        for (int sl = 0; sl < 4; ++sl) { LAS float* T = (LAS float*)F.lds + sl * (64 * 65);
#pragma unroll
            for (int p = 0; p < 2; ++p) { const f4 x = v[2 * sl + p]; const int k = kr + 32 * p;
                T[(4 * c4 + 0) * 65 + k] = x[0]; T[(4 * c4 + 1) * 65 + k] = x[1]; T[(4 * c4 + 2) * 65 + k] = x[2]; T[(4 * c4 + 3) * 65 + k] = x[3]; } }
        __syncthreads();
        conv_store(F, j0, 0, tid); if (t0 + 1 < ntile) conv_store(F, j1, 1, tid); if (t0 + 2 < ntile) conv_store(F, j2, 2, tid); if (t0 + 3 < ntile) conv_store(F, j3, 3, tid);
    }
    __syncthreads();
}
__device__ __forceinline__ void conv_ffn(const Frame& F, int f) { conv_run(F, 0, f); }
__device__ __forceinline__ void conv_inout(const Frame& F) {
    conv_run(F, 1, 0);
    u16* win = (u16*)(F.ws + WS_WIN);
    for (size_t i = (size_t)blockIdx.x * NT + F.tid; i < (size_t)(NWINP - NWIN) * D / 8; i += (size_t)F.G * NT) *(u4*)(win + (size_t)NWIN * D + i * 8) = (u4){0u, 0u, 0u, 0u};
}
__device__ __forceinline__ void mod_gemv(const Frame& F) {
    LAS float* sv = (LAS float*)F.lds;
    LAS float* red = sv + 5 * 2048;
    const int tid = F.tid;
    for (int i = tid; i < 5 * 2048; i += NT) { const int v = i >> 11, k = i & 2047; const float c = v == 0 ? F.cctx[k] : F.cvec[(v - 1) * 2048 + k]; sv[i] = silu_f(c); }
    __syncthreads();
    float* mod = (float*)(F.ws + WS_MOD);
    for (int chunk = blockIdx.x; chunk < 256; chunk += F.G) {
        const int col0 = chunk * 72;
        if (tid < 504) { const int kg = tid / 18, cq = tid % 18;
            f4 a0 = (f4){0.f, 0.f, 0.f, 0.f}, a1 = a0, a2 = a0, a3 = a0, a4 = a0;
#pragma unroll 8
            for (int k = kg; k < 2048; k += 28) { const f4 w = *(const f4*)(F.ada_w + (size_t)k * 18432 + col0 + 4 * cq);
                a0 += sv[k] * w; a1 += sv[2048 + k] * w; a2 += sv[4096 + k] * w; a3 += sv[6144 + k] * w; a4 += sv[8192 + k] * w; }
            LAS float* rp = red + (kg * 18 + cq) * 20;
            *(LAS f4*)(rp + 0) = a0; *(LAS f4*)(rp + 4) = a1; *(LAS f4*)(rp + 8) = a2; *(LAS f4*)(rp + 12) = a3; *(LAS f4*)(rp + 16) = a4; }
        __syncthreads();
        if (tid < 360) { const int v = tid / 72, c = tid % 72, cq = c >> 2, j = c & 3; float s = 0.f;
            for (int kg = 0; kg < 28; ++kg) s += red[(kg * 18 + cq) * 20 + v * 4 + j];
            mod[v * 18432 + col0 + c] = s + F.ada_b[col0 + c]; }
        __syncthreads();
    }
}
__device__ __forceinline__ void filt_h2(const Frame& F) {
    float* tab = (float*)(F.ws + WS_H2TAB);
    for (int p = blockIdx.x * 8 + F.wave; p < 2304; p += F.G * 8) {
        int lane = F.lane; asm volatile("" : "+v"(lane));
        const int L = p < 256 ? 256 : 2048, idx = p < 256 ? p : p - 256;
        const float t = (float)idx / (float)(L - 1), invL = 1.0f / (float)L;
        float a = F.hb1[lane] + t * F.hw1[lane];
#pragma unroll
        for (int b = 1; b <= 16; ++b) { const int m = (idx * b) & (L - 1); const float rev = (float)m * invL;
            a += __builtin_amdgcn_cosf(rev) * F.hw1[b * 64 + lane] + __builtin_amdgcn_sinf(rev) * F.hw1[(16 + b) * 64 + lane]; }
        const float h1 = __sinf(a);
        float a2 = F.hb2[lane];
#pragma unroll 4
        for (int i = 0; i < 64; ++i) a2 += __shfl(h1, i) * F.hw2[i * 64 + lane];
        tab[p * 64 + lane] = __sinf(a2);
    }
}

#define PH(i) ((i) + ((i) >> 3))
__device__ __forceinline__ f2 cmul(f2 a, f2 b) { return (f2){a.x * b.x - a.y * b.y, a.x * b.y + a.y * b.x}; }
__device__ __forceinline__ f2 cmt(f2 a, f2 w, f2 wp) { return w * a.x + wp * a.y; }
__device__ __forceinline__ f2 perp(f2 w) { return (f2){-w.y, w.x}; }
__device__ __forceinline__ void dif8(f2 (&x)[8], f2 w1) {
    const f2 w2 = cmul(w1, w1), w4 = cmul(w2, w2); const float r = 0.70710678118654752f;
    const f2 tA1 = (f2){(w1.x + w1.y) * r, (w1.y - w1.x) * r}, tA2 = (f2){w1.y, -w1.x}, tA3 = (f2){(w1.y - w1.x) * r, -(w1.x + w1.y) * r}, tB1 = (f2){w2.y, -w2.x};
    const f2 w1p = perp(w1), tA1p = perp(tA1), tA2p = perp(tA2), tA3p = perp(tA3), w2p = perp(w2), tB1p = perp(tB1), w4p = perp(w4);
    { f2 a = x[0], b = x[4]; x[0] = a + b; x[4] = cmt(a - b, w1, w1p); a = x[1]; b = x[5]; x[1] = a + b; x[5] = cmt(a - b, tA1, tA1p);
      a = x[2]; b = x[6]; x[2] = a + b; x[6] = cmt(a - b, tA2, tA2p); a = x[3]; b = x[7]; x[3] = a + b; x[7] = cmt(a - b, tA3, tA3p); }
#pragma unroll
    for (int o = 0; o < 8; o += 4) { f2 a = x[o], b = x[o + 2]; x[o] = a + b; x[o + 2] = cmt(a - b, w2, w2p); a = x[o + 1]; b = x[o + 3]; x[o + 1] = a + b; x[o + 3] = cmt(a - b, tB1, tB1p); }
#pragma unroll
    for (int m = 0; m < 8; m += 2) { const f2 a = x[m], b = x[m + 1]; x[m] = a + b; x[m + 1] = cmt(a - b, w4, w4p); }
}
__device__ __forceinline__ void dif8z(f2 (&x)[8], f2 w1) {
    const f2 w2 = cmul(w1, w1), w4 = cmul(w2, w2); const float r = 0.70710678118654752f;
    const f2 tA1 = (f2){(w1.x + w1.y) * r, (w1.y - w1.x) * r}, tA2 = (f2){w1.y, -w1.x}, tA3 = (f2){(w1.y - w1.x) * r, -(w1.x + w1.y) * r}, tB1 = (f2){w2.y, -w2.x};
    const f2 w1p = perp(w1), tA1p = perp(tA1), tA2p = perp(tA2), tA3p = perp(tA3), w2p = perp(w2), tB1p = perp(tB1), w4p = perp(w4);
    x[4] = cmt(x[0], w1, w1p); x[5] = cmt(x[1], tA1, tA1p); x[6] = cmt(x[2], tA2, tA2p); x[7] = cmt(x[3], tA3, tA3p);
#pragma unroll
    for (int o = 0; o < 8; o += 4) { f2 a = x[o], b = x[o + 2]; x[o] = a + b; x[o + 2] = cmt(a - b, w2, w2p); a = x[o + 1]; b = x[o + 3]; x[o + 1] = a + b; x[o + 3] = cmt(a - b, tB1, tB1p); }
#pragma unroll
    for (int m = 0; m < 8; m += 2) { const f2 a = x[m], b = x[m + 1]; x[m] = a + b; x[m + 1] = cmt(a - b, w4, w4p); }
}
__device__ __forceinline__ void dit8(f2 (&x)[8], f2 v1) {
    const f2 v2 = cmul(v1, v1), v4 = cmul(v2, v2); const float r = 0.70710678118654752f;
    const f2 tA1 = (f2){(v1.x - v1.y) * r, (v1.x + v1.y) * r}, tA2 = (f2){-v1.y, v1.x}, tA3 = (f2){-(v1.x + v1.y) * r, (v1.x - v1.y) * r}, tB1 = (f2){-v2.y, v2.x};
    const f2 v1p = perp(v1), tA1p = perp(tA1), tA2p = perp(tA2), tA3p = perp(tA3), v2p = perp(v2), tB1p = perp(tB1), v4p = perp(v4);
#pragma unroll
    for (int m = 0; m < 8; m += 2) { const f2 a = x[m], t = cmt(x[m + 1], v4, v4p); x[m] = a + t; x[m + 1] = a - t; }
#pragma unroll
    for (int o = 0; o < 8; o += 4) { f2 a = x[o], t = cmt(x[o + 2], v2, v2p); x[o] = a + t; x[o + 2] = a - t; a = x[o + 1]; t = cmt(x[o + 3], tB1, tB1p); x[o + 1] = a + t; x[o + 3] = a - t; }
    { f2 a = x[0], t = cmt(x[4], v1, v1p); x[0] = a + t; x[4] = a - t; a = x[1]; t = cmt(x[5], tA1, tA1p); x[1] = a + t; x[5] = a - t;
      a = x[2]; t = cmt(x[6], tA2, tA2p); x[2] = a + t; x[6] = a - t; a = x[3]; t = cmt(x[7], tA3, tA3p); x[3] = a + t; x[7] = a - t; }
}
constexpr int ZS = 4608;
template <int NB> __device__ __forceinline__ void fft_fwd(LAS f2* Z, int Nf, int tid) {
    for (int q = Nf >> 3; q >= 1; q >>= 3) {
        __syncthreads();
        const int jp = tid & (q - 1), base = ((tid - jp) << 3) + jp; const float rev = (float)jp / (float)(8 * q);
        const f2 w1 = (f2){__builtin_amdgcn_cosf(rev), -__builtin_amdgcn_sinf(rev)};
        f2 x[NB][8];
#pragma unroll
        for (int b = 0; b < NB; ++b)
#pragma unroll
            for (int m = 0; m < 8; ++m) x[b][m] = Z[b * ZS + PH(base + m * q)];
#pragma unroll
        for (int b = 0; b < NB; ++b) dif8(x[b], w1);
#pragma unroll
        for (int b = 0; b < NB; ++b)
#pragma unroll
            for (int m = 0; m < 8; ++m) Z[b * ZS + PH(base + m * q)] = x[b][m];
    }
    __syncthreads();
}
template <int NB> __device__ __forceinline__ void fft_inv(LAS f2* Z, int Nf, int tid) {
    for (int q = 1; q <= (Nf >> 3); q <<= 3) {
        __syncthreads();
        const int jp = tid & (q - 1), base = ((tid - jp) << 3) + jp; const float rev = (float)jp / (float)(8 * q);
        const f2 v1 = (f2){__builtin_amdgcn_cosf(rev), __builtin_amdgcn_sinf(rev)};
        f2 x[NB][8];
#pragma unroll
        for (int b = 0; b < NB; ++b)
#pragma unroll
            for (int m = 0; m < 8; ++m) x[b][m] = Z[b * ZS + PH(base + m * q)];
#pragma unroll
        for (int b = 0; b < NB; ++b) dit8(x[b], v1);
#pragma unroll
        for (int b = 0; b < NB; ++b)
#pragma unroll
            for (int m = 0; m < 8; ++m) Z[b * ZS + PH(base + m * q)] = x[b][m];
    }
    __syncthreads();
}
template <int NB> __device__ __forceinline__ void fft_conv(LAS f2* Z, int Nf, int tid, const f2 (&hs)[NB][8]) {
    for (int q = Nf >> 3; q > 1; q >>= 3) {
        __syncthreads();
        const int jp = tid & (q - 1), base = ((tid - jp) << 3) + jp; const float rev = (float)jp / (float)(8 * q);
        const f2 w1 = (f2){__builtin_amdgcn_cosf(rev), -__builtin_amdgcn_sinf(rev)};
        const bool first = (q == (Nf >> 3));
        f2 x[NB][8];
        if (first) {
#pragma unroll
            for (int b = 0; b < NB; ++b) {
#pragma unroll
                for (int m = 0; m < 4; ++m) x[b][m] = Z[b * ZS + PH(base + m * q)];
                dif8z(x[b], w1); }
        } else {
#pragma unroll
            for (int b = 0; b < NB; ++b)
#pragma unroll
                for (int m = 0; m < 8; ++m) x[b][m] = Z[b * ZS + PH(base + m * q)];
#pragma unroll
            for (int b = 0; b < NB; ++b) dif8(x[b], w1);
        }
#pragma unroll
        for (int b = 0; b < NB; ++b)
#pragma unroll
            for (int m = 0; m < 8; ++m) Z[b * ZS + PH(base + m * q)] = x[b][m];
    }
    __syncthreads();
    { const int base = tid << 3; f2 x[NB][8];
#pragma unroll
      for (int b = 0; b < NB; ++b)
#pragma unroll
          for (int m = 0; m < 8; ++m) x[b][m] = Z[b * ZS + PH(base + m)];
#pragma unroll
      for (int b = 0; b < NB; ++b) { dif8(x[b], (f2){1.f, 0.f});
#pragma unroll
          for (int m = 0; m < 8; ++m) x[b][m] = cmul(x[b][m], hs[b][m]);
          dit8(x[b], (f2){1.f, 0.f}); }
#pragma unroll
      for (int b = 0; b < NB; ++b)
#pragma unroll
          for (int m = 0; m < 8; ++m) Z[b * ZS + PH(base + m)] = x[b][m]; }
    for (int q = 8; q <= (Nf >> 3); q <<= 3) {
        __syncthreads();
        const int jp = tid & (q - 1), base = ((tid - jp) << 3) + jp; const float rev = (float)jp / (float)(8 * q);
        const f2 v1 = (f2){__builtin_amdgcn_cosf(rev), __builtin_amdgcn_sinf(rev)};
        f2 x[NB][8];
#pragma unroll
        for (int b = 0; b < NB; ++b)
#pragma unroll
            for (int m = 0; m < 8; ++m) x[b][m] = Z[b * ZS + PH(base + m * q)];
#pragma unroll
        for (int b = 0; b < NB; ++b) dit8(x[b], v1);
#pragma unroll
        for (int b = 0; b < NB; ++b)
#pragma unroll
            for (int m = 0; m < 8; ++m) Z[b * ZS + PH(base + m * q)] = x[b][m];
    }
    __syncthreads();
}
#define C8X(m) ((m) == 0 ? 1.f : (m) == 1 ? 0.92387953251f : (m) == 2 ? 0.70710678119f : (m) == 3 ? 0.38268343237f : (m) == 4 ? 0.f : (m) == 5 ? -0.38268343237f : (m) == 6 ? -0.70710678119f : -0.92387953251f)
#define C8Y(m) ((m) == 0 ? 0.f : (m) == 1 ? 0.38268343237f : (m) == 2 ? 0.70710678119f : (m) == 3 ? 0.92387953251f : (m) == 4 ? 1.f : (m) == 5 ? 0.92387953251f : (m) == 6 ? 0.70710678119f : 0.38268343237f)
template <bool ZHI> __device__ __forceinline__ void dif16(f2 (&lo)[8], f2 (&hi)[8], f2 w0) {
#pragma unroll
    for (int m = 0; m < 8; ++m) { const f2 tw = cmul(w0, (f2){C8X(m), -C8Y(m)}); const f2 a = lo[m];
        if (ZHI) { hi[m] = cmul(a, tw); } else { const f2 b = hi[m]; lo[m] = a + b; hi[m] = cmul(a - b, tw); } }
    const f2 w1 = cmul(w0, w0);
    dif8(lo, w1); dif8(hi, w1);
}
__device__ __forceinline__ void dit16(f2 (&lo)[8], f2 (&hi)[8], f2 v0) {
    const f2 v1 = cmul(v0, v0);
    dit8(lo, v1); dit8(hi, v1);
#pragma unroll
    for (int m = 0; m < 8; ++m) { const f2 tw = cmul(v0, (f2){C8X(m), C8Y(m)}); const f2 a = lo[m], t = cmul(hi[m], tw); lo[m] = a + t; hi[m] = a - t; }
}
__device__ __forceinline__ void fft_conv16(LAS f2* Z, int tid_, const f2* Hs) {
    int tid = tid_;
    asm volatile("" : "+v"(tid));
    LAS f2* Zb = Z + (tid >> 8) * ZS; const int g = tid & 255;
    f2 lo[8], hi[8];
    __syncthreads();
    { const float rev = (float)g * (1.0f / 4096.0f); const f2 w0 = (f2){__builtin_amdgcn_cosf(rev), -__builtin_amdgcn_sinf(rev)};
#pragma unroll
      for (int m = 0; m < 8; ++m) lo[m] = Zb[PH(g + m * 256)];
      dif16<true>(lo, hi, w0);
#pragma unroll
      for (int m = 0; m < 8; ++m) { Zb[PH(g + m * 256)] = lo[m]; Zb[PH(g + (m + 8) * 256)] = hi[m]; } }
    __syncthreads();
    const f4 h0 = *(const f4*)Hs;
    { const int jp = g & 15, base = ((g - jp) << 4) + jp; const float rev = (float)jp * (1.0f / 256.0f); const f2 w0 = (f2){__builtin_amdgcn_cosf(rev), -__builtin_amdgcn_sinf(rev)};
#pragma unroll
      for (int m = 0; m < 8; ++m) { lo[m] = Zb[PH(base + m * 16)]; hi[m] = Zb[PH(base + (m + 8) * 16)]; }
      dif16<false>(lo, hi, w0);
#pragma unroll
      for (int m = 0; m < 8; ++m) { Zb[PH(base + m * 16)] = lo[m]; Zb[PH(base + (m + 8) * 16)] = hi[m]; } }
    __syncthreads();
    f2 hs[16]; hs[0] = (f2){h0[0], h0[1]}; hs[1] = (f2){h0[2], h0[3]};
#pragma unroll
    for (int q = 2; q < 16; q += 2) { const f4 hv = *(const f4*)(Hs + q); hs[q] = (f2){hv[0], hv[1]}; hs[q + 1] = (f2){hv[2], hv[3]}; }
    { const int base = g << 4;
#pragma unroll
      for (int m = 0; m < 8; ++m) { lo[m] = Zb[PH(base + m)]; hi[m] = Zb[PH(base + m + 8)]; }
      dif16<false>(lo, hi, (f2){1.f, 0.f});
#pragma unroll
      for (int m = 0; m < 8; ++m) { lo[m] = cmul(lo[m], hs[m]); hi[m] = cmul(hi[m], hs[m + 8]); }
      dit16(lo, hi, (f2){1.f, 0.f});
#pragma unroll
      for (int m = 0; m < 8; ++m) { Zb[PH(base + m)] = lo[m]; Zb[PH(base + m + 8)] = hi[m]; } }
    __syncthreads();
    { const int jp = g & 15, base = ((g - jp) << 4) + jp; const float rev = (float)jp * (1.0f / 256.0f); const f2 v0 = (f2){__builtin_amdgcn_cosf(rev), __builtin_amdgcn_sinf(rev)};
#pragma unroll
      for (int m = 0; m < 8; ++m) { lo[m] = Zb[PH(base + m * 16)]; hi[m] = Zb[PH(base + (m + 8) * 16)]; }
      dit16(lo, hi, v0);
#pragma unroll
      for (int m = 0; m < 8; ++m) { Zb[PH(base + m * 16)] = lo[m]; Zb[PH(base + (m + 8) * 16)] = hi[m]; } }
    __syncthreads();
    { const float rev = (float)g * (1.0f / 4096.0f); const f2 v0 = (f2){__builtin_amdgcn_cosf(rev), __builtin_amdgcn_sinf(rev)};
#pragma unroll
      for (int m = 0; m < 8; ++m) { lo[m] = Zb[PH(g + m * 256)]; hi[m] = Zb[PH(g + (m + 8) * 256)]; }
      dit16(lo, hi, v0);
#pragma unroll
      for (int m = 0; m < 8; ++m) Zb[PH(g + m * 256)] = lo[m]; }
    __syncthreads();
}
__device__ __forceinline__ float dot64(const f4 (&hr)[16], LAS const float* w) {
    f4 acc = (f4){0.f, 0.f, 0.f, 0.f};
#pragma unroll
    for (int j = 0; j < 16; ++j) acc += hr[j] * *(LAS const f4*)(w + 4 * j);
    return (acc[0] + acc[1]) + (acc[2] + acc[3]);
}
__device__ __forceinline__ void filt_item(const Frame& F, int it) {
    int tid = F.tid; asm volatile("" : "+v"(tid));
    LAS f2* Z = (LAS f2*)F.lds;
    LAS float* w3s = (LAS float*)(F.lds + 4 * ZS * 8);
    LAS float* wsum = w3s + 1024;
    const bool lat = it < 512;
    const int o = lat ? (it >> 8) : ((it - 512) >> 7), c0 = lat ? (it & 255) * 4 : ((it - 512) & 127) * 8, nch = lat ? 4 : 8;
    const int L = lat ? 2048 : 256, Nf = 2 * L;
    const float* tab = (const float*)(F.ws + WS_H2TAB) + (size_t)(lat ? 256 : 0) * 64;
    const float invLm1 = 1.0f / (float)(L - 1);
    __syncthreads();
    for (int i = tid; i < nch * 128; i += NT) { const int ch = i >> 7, dr = (i >> 6) & 1, j = i & 63; w3s[i] = F.hw3[(size_t)j * 4096 + dr * 2048 + o * 1024 + c0 + ch]; }
#pragma unroll
    for (int q = 0; q < 36; ++q) Z[tid + NT * q] = (f2){0.f, 0.f};
    __syncthreads();
    if (lat) {
        const int lane = tid & 63, wv = tid >> 6, l31 = lane & 31, hh = lane >> 5;
        LAS u16* w3b = (LAS u16*)(wsum + 64);
        LAS float* part = wsum + 64 + 1152;
        for (int i = tid; i < 32 * 72; i += NT) { const int n = i / 72, k = i - 72 * n; w3b[i] = (n < 8 && k < 64) ? f2bf(w3s[n * 64 + k]) : (u16)0; }
        __syncthreads();
        bf8 bw[4];
#pragma unroll
        for (int ks = 0; ks < 4; ++ks) bw[ks] = *(LAS bf8*)(w3b + l31 * 72 + 16 * ks + 8 * hh);
        const int nn = l31 & 7, chn = nn >> 1, drn = nn & 1;
        const float decn = fabsf(F.hdecay[o * 1024 + c0 + chn]);
        float sa = 0.f;
#pragma unroll 1
        for (int rtile = wv; rtile < 64; rtile += 8) {
            f16v acc;
#pragma unroll
            for (int j = 0; j < 16; ++j) acc[j] = 0.f;
            const float* hp = tab + (size_t)(32 * rtile + l31) * 64 + 8 * hh;
#pragma unroll
            for (int ks = 0; ks < 4; ++ks) { const f4 a0 = *(const f4*)(hp + 16 * ks), a1 = *(const f4*)(hp + 16 * ks + 4);
                const u4 pk = (u4){pack2(a0[0], a0[1]), pack2(a0[2], a0[3]), pack2(a1[0], a1[1]), pack2(a1[2], a1[3])};
                acc = MFMA32(__builtin_bit_cast(bf8, pk), bw[ks], acc); }
            if (l31 < 8) {
#pragma unroll
                for (int j = 0; j < 16; ++j) { const int pos = 32 * rtile + (j & 3) + 8 * (j >> 2) + 4 * hh; const float v = acc[j] * (__expf(-(float)pos * invLm1 * decn) + 0.05f);
                    if (drn == 0) { Z[chn * ZS + PH(pos)] = (f2){v, 0.f}; sa += fabsf(v); } else if (pos) { Z[chn * ZS + PH(Nf - pos)] = (f2){v, 0.f}; sa += fabsf(v); } } }
        }
        if (l31 < 8) part[(wv * 2 + hh) * 8 + nn] = sa;
        __syncthreads();
        if (tid < 4) { float tot = 0.f;
#pragma unroll
            for (int w = 0; w < 16; ++w) tot += part[w * 8 + 2 * tid] + part[w * 8 + 2 * tid + 1];
            wsum[tid] = tot; }
        __syncthreads();
#pragma unroll
        for (int ch = 0; ch < 4; ++ch) { const float sc = 1.0f / (wsum[ch] * (float)Nf);
#pragma unroll 1
            for (int pp = 0; pp < 4; ++pp) { const int pos = tid + NT * pp; Z[ch * ZS + PH(pos)].x *= sc; if (pos) Z[ch * ZS + PH(Nf - pos)].x *= sc; } }
        fft_fwd<2>(Z, Nf, tid); fft_fwd<2>(Z + 2 * ZS, Nf, tid);
#pragma unroll
        for (int ch = 0; ch < 4; ++ch) { f2* dst = (f2*)(F.ws + WS_HSL) + (size_t)(o * 1024 + c0 + ch) * 4096 + tid * 8;
#pragma unroll
            for (int q = 0; q < 8; q += 2) { const f2 a = Z[ch * ZS + PH(tid * 8 + q)], b = Z[ch * ZS + PH(tid * 8 + q + 1)]; *(f4*)(dst + q) = (f4){a.x, a.y, b.x, b.y}; } }
    } else {
        const int pos = tid & 255, half = tid >> 8;
        f4 hr[16];
#pragma unroll
        for (int j = 0; j < 16; ++j) hr[j] = *(const f4*)(tab + (size_t)pos * 64 + 4 * j);
        float tf[4], tb[4];
#pragma unroll
        for (int ch = 0; ch < 4; ++ch) { const int cc = 4 * half + ch; const float win = __expf(-(float)pos * invLm1 * fabsf(F.hdecay[o * 1024 + c0 + cc])) + 0.05f;
            tf[ch] = dot64(hr, w3s + cc * 128) * win; tb[ch] = pos ? dot64(hr, w3s + cc * 128 + 64) * win : 0.f;
            const float sa = wave_sum(fabsf(tf[ch]) + fabsf(tb[ch])); if (F.lane == 0) wsum[F.wave * 4 + ch] = sa; }
        __syncthreads();
#pragma unroll
        for (int ch = 0; ch < 4; ++ch) { const int cc = 4 * half + ch; float tot = 0.f;
#pragma unroll
            for (int w = 0; w < 4; ++w) tot += wsum[(4 * half + w) * 4 + ch];
            const float sc = 1.0f / (tot * (float)Nf);
            Z[PH(cc * 512 + pos)] = (f2){tf[ch] * sc, 0.f}; if (pos) Z[PH(cc * 512 + Nf - pos)] = (f2){tb[ch] * sc, 0.f}; }
        fft_fwd<1>(Z, Nf, tid);
        { const int e0 = tid * 8, pch = e0 >> 9, n0 = e0 & 511; f2* dst = (f2*)(F.ws + WS_HSC) + (size_t)(o * 1024 + c0 + pch) * 512 + n0;
#pragma unroll
          for (int q = 0; q < 8; q += 2) { const f2 a = Z[PH(e0 + q)], b = Z[PH(e0 + q + 1)]; *(f4*)(dst + q) = (f4){a.x, a.y, b.x, b.y}; } }
    }
}

__device__ __forceinline__ void load_x0(const Frame& F, int r, int lane, f4 (&x)[8]) {
    if (r < MCTX) { const f4* p = (const f4*)(F.x_prompt + (size_t)r * D);
#pragma unroll
        for (int i = 0; i < 8; ++i) x[i] = p[i * 64 + lane]; }
    else { const int rr = r - MCTX; const f4* p = (const f4*)(F.x_sample + (size_t)rr * D); const int t = rr & 2047; const float gr = (float)(t >> 6), gc = (float)(t & 63);
#pragma unroll
        for (int i = 0; i < 8; ++i) { f4 v = p[i * 64 + lane]; const int col = (i * 64 + lane) * 4, ii = col & 511; const float pos = (i < 4) ? gr : gc;
#pragma unroll
            for (int j = 0; j < 4; ++j) { const float om = __builtin_amdgcn_exp2f(-(float)(ii + j) * (13.287712379549449f / 512.0f)); const float a = pos * om * 0.15915494309189535f;
                v[j] += ((i >> 1) & 1) ? __builtin_amdgcn_cosf(a) : __builtin_amdgcn_sinf(a); }
            x[i] = v; } }
}
__device__ __forceinline__ void adaln_store(const Frame& F, int r, int lane, const f4 (&x)[8], int pre_i, int shift_i, int scale_i) {
    float ss = 0.f;
#pragma unroll
    for (int i = 0; i < 8; ++i) ss += x[i][0] * x[i][0] + x[i][1] * x[i][1] + x[i][2] * x[i][2] + x[i][3] * x[i][3];
    ss = wave_sum(ss);
    const float rs = rsqrtf(ss * (1.0f / D) + RMS_EPS);
    const float* md = (const float*)(F.ws + WS_MOD) + (size_t)modidx(r) * 18432;
    u16* H = (u16*)(F.ws + WS_H) + (size_t)r * D;
#pragma unroll
    for (int i = 0; i < 8; ++i) { const int col = (i * 64 + lane) * 4;
        const f4 g = *(const f4*)(F.npre + pre_i * D + col), sh = *(const f4*)(md + shift_i * D + col), sc = *(const f4*)(md + scale_i * D + col);
        const f4 hv = x[i] * rs * g * (1.0f + sc) + sh;
        u2 w; w.x = pack2(hv[0], hv[1]); w.y = pack2(hv[2], hv[3]); *(u2*)(H + col) = w; }
}
__device__ __forceinline__ void phase_adaln1(const Frame& F) {
    for (int r = blockIdx.x * 8 + F.wave; r < MROWS; r += F.G * 8) { f4 x[8]; load_x0(F, r, F.lane, x); adaln_store(F, r, F.lane, x, 0, 0, 1); }
}
__device__ __forceinline__ void phase_res(const Frame& F, int which) {
    const u16* Y = (const u16*)(F.ws + WS_Y); const u16* Y1 = (const u16*)(F.ws + WS_Y1);
    const int gate_i = which == 0 ? 2 : (which == 1 ? 5 : 8); const float gsc = which == 1 ? 1.0f : 0.5f;
    for (int r = blockIdx.x * 8 + F.wave; r < MROWS; r += F.G * 8) {
        const int lane = F.lane; f4 x[8];
        float* X = F.out + (size_t)r * D;
        if (which == 0) load_x0(F, r, lane, x);
        else {
#pragma unroll
            for (int i = 0; i < 8; ++i) x[i] = *(const f4*)(X + (i * 64 + lane) * 4); }
        f4 y[8]; float ss = 0.f;
#pragma unroll
        for (int i = 0; i < 8; ++i) { { const u2 a = *(const u2*)(Y + (size_t)r * D + (i * 64 + lane) * 4), b = *(const u2*)(Y1 + (size_t)r * D + (i * 64 + lane) * 4); y[i] = (f4){bflo(a.x) + bflo(b.x), bfhi(a.x) + bfhi(b.x), bflo(a.y) + bflo(b.y), bfhi(a.y) + bfhi(b.y)}; } ss += y[i][0] * y[i][0] + y[i][1] * y[i][1] + y[i][2] * y[i][2] + y[i][3] * y[i][3]; }
        ss = wave_sum(ss);
        const float rs = rsqrtf(ss * (1.0f / D) + RMS_EPS) * gsc;
        const float* md = (const float*)(F.ws + WS_MOD) + (size_t)modidx(r) * 18432;
#pragma unroll
        for (int i = 0; i < 8; ++i) { const int col = (i * 64 + lane) * 4;
            const f4 g = *(const f4*)(F.npost + which * D + col), gt = *(const f4*)(md + gate_i * D + col);
            x[i] += gt * (y[i] * rs * g);
            *(f4*)(X + col) = x[i]; }
        if (which == 0) adaln_store(F, r, lane, x, 1, 3, 4);
        else if (which == 1) adaln_store(F, r, lane, x, 2, 6, 7);
    }
}

struct GdnRaw { u2 m[4], l[4], rt[4]; };
__device__ __forceinline__ void gdn_tile_fetch(const u16* PG, int r0, int seq_start, int seq_end, int colbase, int tid, GdnRaw& R) {
    const int c4 = tid & 31, tr = tid >> 5, col = colbase + 4 * c4;
#pragma unroll
    for (int p = 0; p < 4; ++p) { const int r = r0 + tr + 16 * p; const u16* pr = PG + (size_t)r * NGD + col;
        R.m[p] = *(const u2*)pr; R.l[p] = (u2){0u, 0u}; R.rt[p] = (u2){0u, 0u};
        if (r > seq_start) R.l[p] = *(const u2*)(pr - NGD);
        if (r + 1 < seq_end) R.rt[p] = *(const u2*)(pr + NGD); }
}
template <int MODE>
__device__ __forceinline__ void gdn_tile_finish(const GdnRaw& R, const float* cw, int r0, int colbase, LAS float* dstf, LAS unsigned char* dstb, u16* dstg, int tid) {
    const int c4 = tid & 31, tr = tid >> 5, col = colbase + 4 * c4;
    const f4 w0 = *(const f4*)(cw + col), w1 = *(const f4*)(cw + 3072 + col), w2 = *(const f4*)(cw + 6144 + col);
#pragma unroll
    for (int p = 0; p < 4; ++p) { const int i = tr + 16 * p; f4 v; const u2 l = R.l[p], m = R.m[p], rt = R.rt[p];
        v[0] = w0[0] * bflo(l.x) + w1[0] * bflo(m.x) + w2[0] * bflo(rt.x); v[1] = w0[1] * bfhi(l.x) + w1[1] * bfhi(m.x) + w2[1] * bfhi(rt.x);
        v[2] = w0[2] * bflo(l.y) + w1[2] * bflo(m.y) + w2[2] * bflo(rt.y); v[3] = w0[3] * bfhi(l.y) + w1[3] * bfhi(m.y) + w2[3] * bfhi(rt.y);
        v[0] = silu_f(v[0]); v[1] = silu_f(v[1]); v[2] = silu_f(v[2]); v[3] = silu_f(v[3]);
        if (MODE < 2) { float ss = v[0] * v[0] + v[1] * v[1] + v[2] * v[2] + v[3] * v[3];
            ss += __shfl_xor(ss, 1); ss += __shfl_xor(ss, 2); ss += __shfl_xor(ss, 4); ss += __shfl_xor(ss, 8); ss += __shfl_xor(ss, 16);
            v *= rsqrtf(ss + RMS_EPS) * (MODE == 0 ? 0.08838834764831845f : 1.0f);
            const u2 wv = (u2){pack2(v[0], v[1]), pack2(v[2], v[3])};
            *(LAS u2*)(dstb + (i * 136 + 4 * c4) * 2) = wv;
            if (MODE == 0) *(u2*)(dstg + (size_t)(r0 + i) * 1024 + 4 * c4) = wv; }
        if (MODE > 0) *(LAS f4*)(dstf + i * 132 + 4 * c4) = v; }
}
template <int I> struct FwdSub {
    static __device__ __forceinline__ void run(f2 (&x)[64], LAS const float* Ad, LAS const float* sc, LAS const float* src, int rstep) {
        FwdSub<I - 1>::run(x, Ad, sc, src, rstep);
        const float eg = sc[I];
        f2 s0 = *(LAS const f2*)(src + I * rstep) * eg, s1 = (f2){0.f, 0.f};
#pragma unroll
        for (int j4 = 0; j4 < (I + 3) / 4; ++j4) { const f4 a = *(LAS const f4*)(Ad + I * 64 + 4 * j4);
            if (4 * j4 + 0 < I) s0 -= x[4 * j4 + 0] * a[0]; if (4 * j4 + 1 < I) s1 -= x[4 * j4 + 1] * a[1]; if (4 * j4 + 2 < I) s0 -= x[4 * j4 + 2] * a[2]; if (4 * j4 + 3 < I) s1 -= x[4 * j4 + 3] * a[3]; }
        x[I] = s0 + s1;
        asm volatile("" ::: "memory");
    }
};
template <> struct FwdSub<-1> { static __device__ __forceinline__ void run(f2 (&)[64], LAS const float*, LAS const float*, LAS const float*, int) {} };
__device__ __forceinline__ void gdn_prep_item(const Frame& F, int item) {
    int tid = F.tid; asm volatile("" : "+v"(tid));
    const int cb = item >> 3, h = item & 7, r0 = cb * 64;
    int seq_start, seq_end;
    if (r0 < MCTX) { seq_start = r0 & ~255; seq_end = seq_start + 256; } else { seq_start = MCTX + ((r0 - MCTX) & ~2047); seq_end = seq_start + 2048; }
    LAS float* Kt = (LAS float*)F.lds; LAS float* Qt = Kt + 64 * 132; LAS float* G = Qt + 64 * 132; LAS float* P = G + 64 * 65; LAS float* A = P + 64 * 65;
    LAS float* gcs = A + 8704; LAS float* bts = gcs + 128; LAS float* ekd = bts + 128; LAS float* beg = ekd + 128;
    LAS unsigned char* Kb = (LAS unsigned char*)A; LAS unsigned char* Qb = Kb + 17408;
    const u16* PG = (const u16*)(F.ws + WS_PG);
    __syncthreads();
    { GdnRaw Rq, Rk, Rv;
      gdn_tile_fetch(PG, r0, seq_start, seq_end, h * 128, tid, Rq); gdn_tile_fetch(PG, r0, seq_start, seq_end, 1024 + h * 128, tid, Rk); gdn_tile_fetch(PG, r0, seq_start, seq_end, 2048 + h * 128, tid, Rv);
      gdn_tile_finish<0>(Rq, F.g_conv, r0, h * 128, nullptr, Qb, (u16*)(F.ws + WS_QN) + h * 128, tid);
      gdn_tile_finish<1>(Rk, F.g_conv, r0, 1024 + h * 128, Kt, Kb, nullptr, tid);
      gdn_tile_finish<2>(Rv, F.g_conv, r0, 2048 + h * 128, Qt, nullptr, nullptr, tid); }
    { const int i = tid >> 3, seg = tid & 7; const u16* zp = PG + (size_t)(r0 + i) * NGD + 3072 + h * 128 + seg * 16; u16* sp = (u16*)(F.ws + WS_SZ) + (size_t)(r0 + i) * 1024 + h * 128 + seg * 16;
#pragma unroll
      for (int q = 0; q < 2; ++q) { const u4 z = *(const u4*)(zp + 8 * q); u4 w;
          w.x = pack2(silu_f(bflo(z.x)), silu_f(bfhi(z.x))); w.y = pack2(silu_f(bflo(z.y)), silu_f(bfhi(z.y))); w.z = pack2(silu_f(bflo(z.z)), silu_f(bfhi(z.z))); w.w = pack2(silu_f(bflo(z.w)), silu_f(bfhi(z.w)));
          *(u4*)(sp + 8 * q) = w; } }
    if (tid < 128) { const int d = tid >> 6, i = tid & 63, r = d ? r0 + 63 - i : r0 + i;
        const u16* abp = PG + (size_t)r * NGD + 4096 + d * 16;
        const float ad = bf2f(abp[h]) + F.g_dtb[d * 8 + h], ab = bf2f(abp[8 + h]);
        const float sp = ad > 20.f ? ad : log1pf(__expf(ad));
        const float g = -__expf(F.g_alog[d * 8 + h]) * sp, beta = 1.0f / (1.0f + __expf(-ab));
        float cs = g;
#pragma unroll
        for (int o = 1; o < 64; o <<= 1) { const float t = __shfl_up(cs, o); if (i >= o) cs += t; }
        gcs[d * 64 + i] = cs; bts[d * 64 + i] = beta; ekd[d * 64 + i] = __expf(__shfl(cs, 63) - cs); beg[d * 64 + i] = beta * __expf(cs);
        ((float*)(F.ws + WS_GC))[(size_t)(d * NITEM_PREP + item) * 64 + i] = cs; }
    __syncthreads();
    { u16* kdt = (u16*)(F.ws + WS_KN);
#pragma unroll
      for (int p = 0; p < 4; ++p) { const int e = tid + NT * p, d = e >> 10, krow = e & 127, seg = (e >> 7) & 7; float v[8];
          const f4 e0 = *(LAS f4*)(ekd + d * 64 + 8 * seg), e1 = *(LAS f4*)(ekd + d * 64 + 8 * seg + 4);
#pragma unroll
          for (int q = 0; q < 8; ++q) { const int cc = 8 * seg + q, ri = d ? 63 - cc : cc; v[q] = Kt[ri * 132 + krow] * (q < 4 ? e0[q & 3] : e1[q & 3]); }
          *(u4*)(kdt + (size_t)(d * NITEM_PREP + item) * 8192 + krow * 64 + 8 * seg) = (u4){pack2(v[0], v[1]), pack2(v[2], v[3]), pack2(v[4], v[5]), pack2(v[6], v[7])}; } }
    { const int lane = tid & 63, wv = tid >> 6, l31 = lane & 31, hh = lane >> 5, it = (wv >> 1) & 1, jt = wv & 1;
      LAS unsigned char* Ab = (wv < 4) ? Kb : Qb; LAS float* Out = (wv < 4) ? G : P;
      f16v acc;
#pragma unroll
      for (int j = 0; j < 16; ++j) acc[j] = 0.f;
#pragma unroll
      for (int ks = 0; ks < 8; ++ks) { const int ko = 16 * ks + 8 * hh;
          const bf8 af = *(LAS bf8*)(Ab + ((32 * it + l31) * 136 + ko) * 2), bf = *(LAS bf8*)(Kb + ((32 * jt + l31) * 136 + ko) * 2);
          acc = MFMA32(af, bf, acc); }
#pragma unroll
      for (int j = 0; j < 16; ++j) Out[(32 * it + (j & 3) + 8 * (j >> 2) + 4 * hh) * 65 + 32 * jt + l31] = acc[j]; }
    __syncthreads();
    { u16* att = (u16*)(F.ws + WS_ATT);
#pragma unroll
      for (int p = 0; p < 2; ++p) { const int c = tid + NT * p, d = c >> 9, i = (c >> 3) & 63, j0 = (c & 7) * 8, ri = d ? 63 - i : i;
          const float gci = gcs[d * 64 + i], bi = bts[d * 64 + i];
          const f4 g0 = *(LAS f4*)(gcs + d * 64 + j0), g1 = *(LAS f4*)(gcs + d * 64 + j0 + 4);
          float av[8], tv[8];
#pragma unroll
          for (int jj = 0; jj < 8; ++jj) { const int j = j0 + jj, rj = d ? 63 - j : j; const float gcj = jj < 4 ? g0[jj & 3] : g1[jj & 3];
              const float dec = __expf(fminf(gci - gcj, 0.f)); const float pv = P[ri * 65 + rj], gv = G[ri * 65 + rj];
              tv[jj] = (i >= j) ? pv * dec : 0.f; av[jj] = (i > j) ? bi * gv * dec : 0.f; }
          *(LAS f4*)(A + d * 4096 + i * 64 + j0) = (f4){av[0], av[1], av[2], av[3]}; *(LAS f4*)(A + d * 4096 + i * 64 + j0 + 4) = (f4){av[4], av[5], av[6], av[7]};
          *(u4*)(att + (size_t)(d * NITEM_PREP + item) * 4096 + i * 64 + j0) = (u4){pack2(tv[0], tv[1]), pack2(tv[2], tv[3]), pack2(tv[4], tv[5]), pack2(tv[6], tv[7])}; } }
    __syncthreads();
    if (tid < 256) { const int d = tid >> 7, col = (tid & 127) * 2; LAS const float* Ad = A + d * 4096; LAS const float* Vt = Qt;
      f2 x[64];
      LAS const float* src = ((col < 128) ? Vt : Kt) + (col & 127) + (d ? 63 * 132 : 0);
      FwdSub<63>::run(x, Ad, ((col < 128) ? bts : beg) + d * 64, src, d ? -132 : 132);
      if (col < 128) { u16* dst = (u16*)(F.ws + WS_U) + (size_t)(d * NITEM_PREP + item) * 8192 + col * 64;
#pragma unroll
          for (int i = 0; i < 64; i += 8) { *(u4*)(dst + i) = (u4){pack2(x[i].x, x[i + 1].x), pack2(x[i + 2].x, x[i + 3].x), pack2(x[i + 4].x, x[i + 5].x), pack2(x[i + 6].x, x[i + 7].x)};
              *(u4*)(dst + 64 + i) = (u4){pack2(x[i].y, x[i + 1].y), pack2(x[i + 2].y, x[i + 3].y), pack2(x[i + 4].y, x[i + 5].y), pack2(x[i + 6].y, x[i + 7].y)}; } }
      else { unsigned* dst = (unsigned*)((u16*)(F.ws + WS_W) + (size_t)(d * NITEM_PREP + item) * 8192 + (col - 128));
#pragma unroll
          for (int i = 0; i < 64; ++i) dst[i * 64] = pack2(-x[i].x, -x[i].y); } }
}

constexpr int SC_WN = 0, SC_QB = 17408, SC_ST = 34816, SC_AT = 69632, SC_VNT = 78848, SC_VST = 97280, SC_KDT = 115712, SC_GT = 134144;
__device__ __forceinline__ void gdn_chain_item(const Frame& F, int chain) {
    int tid = F.tid; asm volatile("" : "+v"(tid));
    const int lane = tid & 63, wv = tid >> 6, l31 = lane & 31, hh = lane >> 5;
    int c, s;
    if (chain < 64) { c = chain; s = 16 + (c >> 4); } else { c = chain - 64; s = c >> 4; }
    const int h = (c >> 1) & 7, d = c & 1;
    const int L = s < 16 ? 256 : 2048, rowbase = s < 16 ? s * 256 : MCTX + (s - 16) * 2048, nc = L >> 6, cb0 = rowbase >> 6;
    LAS unsigned char* lds = F.lds;
    LAS float* gt = (LAS float*)(lds + SC_GT);
    const u16* Wg = (const u16*)(F.ws + WS_W); const u16* Ug = (const u16*)(F.ws + WS_U); const u16* QN = (const u16*)(F.ws + WS_QN); const u16* KD = (const u16*)(F.ws + WS_KN);
    const u16* ATT = (const u16*)(F.ws + WS_ATT); const float* GC = (const float*)(F.ws + WS_GC);
    u16* OX = (u16*)(F.ws + (d ? WS_OB : WS_OF));
    const int rt = wv >> 2, ct = wv & 3;
    const int kt = wv >> 1, vt0 = (wv & 1) * 2;
    u4 pW[2], pQ[2], pK[2], pA; u2 pU[4]; float pg = 0.f, pgl = 0.f;
#define SC_FETCH(n_) do { const int cb_ = d ? cb0 + nc - 1 - (n_) : cb0 + (n_), it_ = cb_ * 8 + h, r0_ = cb_ * 64; const size_t tb_ = (size_t)(d * NITEM_PREP + it_); \
        _Pragma("unroll") for (int p = 0; p < 2; ++p) { const int e = tid + NT * p, row = e >> 4, seg = e & 15, trow = d ? r0_ + 63 - row : r0_ + row; \
            pW[p] = *(const u4*)(Wg + tb_ * 8192 + row * 128 + seg * 8); pQ[p] = *(const u4*)(QN + (size_t)trow * 1024 + h * 128 + seg * 8); \
            pK[p] = *(const u4*)(KD + tb_ * 8192 + (e >> 3) * 64 + (e & 7) * 8); } \
        pA = *(const u4*)(ATT + tb_ * 4096 + (tid >> 3) * 64 + (tid & 7) * 8); \
        _Pragma("unroll") for (int q = 0; q < 4; ++q) pU[q] = *(const u2*)(Ug + tb_ * 8192 + (32 * ct + l31) * 64 + 32 * rt + 8 * q + 4 * hh); \
        pgl = GC[tb_ * 64 + 63]; if (tid < 64) pg = GC[tb_ * 64 + tid]; } while (0)
#define SC_COMMIT() do { \
        _Pragma("unroll") for (int p = 0; p < 2; ++p) { const int e = tid + NT * p, row = e >> 4, seg = e & 15; \
            *(LAS u4*)(lds + SC_WN + (row * 136 + seg * 8) * 2) = pW[p]; *(LAS u4*)(lds + SC_QB + (row * 136 + seg * 8) * 2) = pQ[p]; \
            *(LAS u4*)(lds + SC_KDT + ((e >> 3) * 72 + (e & 7) * 8) * 2) = pK[p]; } \
        *(LAS u4*)(lds + SC_AT + ((tid >> 3) * 72 + (tid & 7) * 8) * 2) = pA; \
        if (tid < 64) gt[tid] = __expf(pg); } while (0)
    f16v accS[2];
#pragma unroll
    for (int t = 0; t < 2; ++t)
#pragma unroll
        for (int j = 0; j < 16; ++j) { const int k = 32 * kt + (j & 3) + 8 * (j >> 2) + 4 * hh, v = 32 * (vt0 + t) + l31;
            accS[t][j] = (s >= 16) ? F.state[((size_t)((s - 16) * 2 + d) * 8 + h) * 16384 + k * 128 + v] : 0.f; }
    __syncthreads();
    SC_FETCH(0);
    for (int n = 0; n < nc; ++n) {
#pragma unroll
        for (int t = 0; t < 2; ++t)
#pragma unroll
            for (int q = 0; q < 4; ++q) { const int v = 32 * (vt0 + t) + l31, k0 = 32 * kt + 8 * q + 4 * hh;
                *(LAS u2*)(lds + SC_ST + (v * 136 + k0) * 2) = (u2){pack2(accS[t][4 * q], accS[t][4 * q + 1]), pack2(accS[t][4 * q + 2], accS[t][4 * q + 3])}; }
        SC_COMMIT();
        f16v accT, accO;
#pragma unroll
        for (int q = 0; q < 4; ++q) { accT[4 * q] = bflo(pU[q].x); accT[4 * q + 1] = bfhi(pU[q].x); accT[4 * q + 2] = bflo(pU[q].y); accT[4 * q + 3] = bfhi(pU[q].y); }
#pragma unroll
        for (int j = 0; j < 16; ++j) accO[j] = 0.f;
        const float eglast = __expf(pgl);
        const int cb = d ? cb0 + nc - 1 - n : cb0 + n, r0 = cb * 64;
        __syncthreads();
        if (n + 1 < nc) SC_FETCH(n + 1);
#pragma unroll
        for (int ks = 0; ks < 8; ++ks) { const int ko = 16 * ks + 8 * hh;
            const bf8 aw = *(LAS bf8*)(lds + SC_WN + ((32 * rt + l31) * 136 + ko) * 2), aq = *(LAS bf8*)(lds + SC_QB + ((32 * rt + l31) * 136 + ko) * 2);
            const bf8 bs = *(LAS bf8*)(lds + SC_ST + ((32 * ct + l31) * 136 + ko) * 2);
            accT = MFMA32(aw, bs, accT); accO = MFMA32(aq, bs, accO); }
#pragma unroll
        for (int q = 0; q < 4; ++q) { const int c0 = 32 * rt + 8 * q + 4 * hh, v = 32 * ct + l31; const f4 eq = *(LAS f4*)(gt + c0);
            *(LAS u2*)(lds + SC_VNT + (v * 72 + c0) * 2) = (u2){pack2(accT[4 * q], accT[4 * q + 1]), pack2(accT[4 * q + 2], accT[4 * q + 3])};
            accO[4 * q] *= eq[0]; accO[4 * q + 1] *= eq[1]; accO[4 * q + 2] *= eq[2]; accO[4 * q + 3] *= eq[3]; }
        __syncthreads();
#pragma unroll
        for (int ks = 0; ks < 4; ++ks) { const int ko = 16 * ks + 8 * hh;
            const bf8 aa = *(LAS bf8*)(lds + SC_AT + ((32 * rt + l31) * 72 + ko) * 2), bv = *(LAS bf8*)(lds + SC_VNT + ((32 * ct + l31) * 72 + ko) * 2);
            accO = MFMA32(aa, bv, accO); }
#pragma unroll
        for (int j = 0; j < 16; ++j) { const int i = 32 * rt + (j & 3) + 8 * (j >> 2) + 4 * hh, trow = d ? r0 + 63 - i : r0 + i;
            OX[(size_t)trow * 1024 + h * 128 + 32 * ct + l31] = f2bf(accO[j]); }
#pragma unroll
        for (int t = 0; t < 2; ++t)
#pragma unroll
            for (int j = 0; j < 16; ++j) accS[t][j] *= eglast;
#pragma unroll
        for (int ks = 0; ks < 4; ++ks) { const int ko = 16 * ks + 8 * hh;
            const bf8 ak = *(LAS bf8*)(lds + SC_KDT + ((32 * kt + l31) * 72 + ko) * 2);
#pragma unroll
            for (int t = 0; t < 2; ++t) { const bf8 bv = *(LAS bf8*)(lds + SC_VNT + ((32 * (vt0 + t) + l31) * 72 + ko) * 2); accS[t] = MFMA32(ak, bv, accS[t]); } }
        __syncthreads();
    }
    if (s < 16) {
#pragma unroll
        for (int t = 0; t < 2; ++t)
#pragma unroll
            for (int j = 0; j < 16; ++j) { const int k = 32 * kt + (j & 3) + 8 * (j >> 2) + 4 * hh, v = 32 * (vt0 + t) + l31;
                F.out[(size_t)MROWS * D + ((size_t)(s * 2 + d) * 8 + h) * 16384 + k * 128 + v] = accS[t][j]; } }
#undef SC_FETCH
#undef SC_COMMIT
}

__device__ __forceinline__ void hy_load_conv(const u16* PT, const float* cw, int ch, int tb, int tau, int L, float (&pc)[8]) {
    const u16* p = PT + (size_t)ch * MROWS + tb + tau;
    const u4 m = *(const u4*)p; float v[10];
    v[0] = (tau & (L - 1)) ? bf2f(p[-1]) : 0.f; v[9] = ((tau + 8) & (L - 1)) ? bf2f(p[8]) : 0.f;
    v[1] = bflo(m.x); v[2] = bfhi(m.x); v[3] = bflo(m.y); v[4] = bfhi(m.y); v[5] = bflo(m.z); v[6] = bfhi(m.z); v[7] = bflo(m.w); v[8] = bfhi(m.w);
    const float w0 = cw[ch], w1 = cw[3072 + ch], w2 = cw[6144 + ch];
#pragma unroll
    for (int q = 0; q < 8; ++q) pc[q] = w0 * v[q] + w1 * v[q + 1] + w2 * v[q + 2];
}
__device__ __forceinline__ void hyena_item(const Frame& F, int hitem) {
    int tid = F.tid; asm volatile("" : "+v"(tid));
    const bool lat = hitem < 1024;
    const int c0 = 2 * (lat ? (hitem >> 1) : (hitem - 1024)), tb = lat ? MCTX + (hitem & 1) * 4096 : 0, L = lat ? 2048 : 256, Nf = 2 * L;
    LAS f2* Z = (LAS f2*)F.lds; LAS float* Zf = (LAS float*)F.lds;
    const u16* PT = (const u16*)(F.ws + WS_PT);
    const int tau = tid * 8, sq = tau / L, t = tau & (L - 1), zi = PH((sq >> 1) * Nf + t), comp = sq & 1;
    float u[2][8], x1[2][8], x2[2][8];
#pragma unroll
    for (int b = 0; b < 2; ++b) { hy_load_conv(PT, F.hy_conv, c0 + b, tb, tau, L, u[b]); hy_load_conv(PT, F.hy_conv, 1024 + c0 + b, tb, tau, L, x1[b]); hy_load_conv(PT, F.hy_conv, 2048 + c0 + b, tb, tau, L, x2[b]); }
    __syncthreads();
#pragma unroll
    for (int b = 0; b < 2; ++b)
#pragma unroll
        for (int q = 0; q < 8; ++q) Zf[2 * (b * ZS + zi + q) + comp] = u[b][q];
#pragma unroll 1
    for (int o = 0; o < 2; ++o) {
        if (lat) { fft_conv16(Z, tid, (const f2*)(F.ws + WS_HSL) + (size_t)(o * 1024 + c0 + (tid >> 8)) * 4096 + (tid & 255) * 16);
        } else { f2 hreg[2][8];
#pragma unroll
            for (int b = 0; b < 2; ++b) { const f2* Hs = (const f2*)(F.ws + WS_HSC) + (size_t)(o * 1024 + c0 + b) * 512 + ((tid * 8) & 511);
#pragma unroll
                for (int q = 0; q < 8; q += 2) { const f4 hv = *(const f4*)(Hs + q); hreg[b][q] = (f2){hv[0], hv[1]}; hreg[b][q + 1] = (f2){hv[2], hv[3]}; } }
            fft_conv<2>(Z, Nf, tid, hreg); }
        float y[2][8];
#pragma unroll
        for (int b = 0; b < 2; ++b) { const float bias = F.hbias[o * 1024 + c0 + b];
#pragma unroll
            for (int q = 0; q < 8; ++q) y[b][q] = Zf[2 * (b * ZS + zi + q) + comp] + u[b][q] * bias; }
        if (o == 0) {
#pragma unroll
            for (int b = 0; b < 2; ++b)
#pragma unroll
                for (int q = 0; q < 8; ++q) u[b][q] = x1[b][q] * y[b][q];
            __syncthreads();
#pragma unroll
            for (int b = 0; b < 2; ++b)
#pragma unroll
                for (int q = 0; q < 8; ++q) Zf[2 * (b * ZS + zi + q) + comp] = u[b][q];
        } else {
#pragma unroll
            for (int b = 0; b < 2; ++b) { u16* zo = (u16*)(F.ws + WS_ZHT) + (size_t)(c0 + b) * MROWS + tb + tau;
                *(u4*)zo = (u4){pack2(x2[b][0] * y[b][0], x2[b][1] * y[b][1]), pack2(x2[b][2] * y[b][2], x2[b][3] * y[b][3]), pack2(x2[b][4] * y[b][4], x2[b][5] * y[b][5]), pack2(x2[b][6] * y[b][6], x2[b][7] * y[b][7])}; }
        }
    }
}

__device__ __forceinline__ int rot24(int t, int s) { const int x = t + s; return x >= 24 ? x - 24 : x; }
__device__ __forceinline__ void hy_out_item(const Frame& F, int tile) {
    int tid = F.tid; asm volatile("" : "+v"(tid)); const int t0 = tile * 24;
    LAS float* T = (LAS float*)F.lds;
    LAS float* red = T + 1024 * 25;
    LAS float* rsv = red + 384;
    const u16* ZHT = (const u16*)(F.ws + WS_ZHT);
    __syncthreads();
#pragma unroll 3
    for (int p = 0; p < 6; ++p) { const int e = tid + NT * p, c = e / 3, q = e - 3 * c, sh = (c >> 3) % 24; const u4 v = *(const u4*)(ZHT + (size_t)c * MROWS + t0 + 8 * q); LAS float* tp = T + c * 25;
        const float f[8] = {bflo(v.x), bfhi(v.x), bflo(v.y), bfhi(v.y), bflo(v.z), bfhi(v.z), bflo(v.w), bfhi(v.w)};
#pragma unroll
        for (int jj = 0; jj < 8; ++jj) tp[rot24(8 * q + jj, sh)] = f[jj]; }
    __syncthreads();
    if (tid < 384) { const int t = tid % 24, cg_ = tid / 24; float s = 0.f;
      for (int k8 = 0; k8 < 8; ++k8) { const int c8 = cg_ * 8 + k8, col = rot24(t, c8 % 24);
#pragma unroll
          for (int k = 0; k < 8; ++k) { const float v = T[(8 * c8 + k) * 25 + col]; s += v * v; } }
      red[cg_ * 24 + t] = s; }
    __syncthreads();
    if (tid < 24) { float s = 0.f;
#pragma unroll
        for (int g = 0; g < 16; ++g) s += red[g * 24 + tid];
        rsv[tid] = rsqrtf(s * (1.0f / 1024.0f) + RMS_EPS); }
    __syncthreads();
    u16* YM = (u16*)(F.ws + WS_H);
#pragma unroll 2
    for (int p = 0; p < 6; ++p) { const int e = tid + NT * p, t = e >> 7, c8 = e & 127, col = rot24(t, c8 % 24); const float rs = rsv[t]; float v[8];
#pragma unroll
        for (int k = 0; k < 8; ++k) v[k] = T[(8 * c8 + k) * 25 + col] * rs * F.hnorm[8 * c8 + k];
        *(u4*)(YM + (size_t)(t0 + t) * D + 8 * c8) = (u4){pack2(v[0], v[1]), pack2(v[2], v[3]), pack2(v[4], v[5]), pack2(v[6], v[7])}; }
}
__device__ __forceinline__ void gdn_out_rows(const Frame& F) {
    const u16* OF = (const u16*)(F.ws + WS_OF); const u16* OB = (const u16*)(F.ws + WS_OB); const u16* SZ = (const u16*)(F.ws + WS_SZ); u16* YM = (u16*)(F.ws + WS_H);
    const int lane = F.lane, col = (lane >> 3) * 128 + (lane & 7) * 16;
    for (int r = blockIdx.x * 8 + F.wave; r < MROWS; r += F.G * 8) {
        float o[16]; float ss = 0.f;
#pragma unroll
        for (int q = 0; q < 2; ++q) { const u4 a = *(const u4*)(OF + (size_t)r * 1024 + col + 8 * q), b = *(const u4*)(OB + (size_t)r * 1024 + col + 8 * q);
            o[8 * q + 0] = bflo(a.x) + bflo(b.x); o[8 * q + 1] = bfhi(a.x) + bfhi(b.x); o[8 * q + 2] = bflo(a.y) + bflo(b.y); o[8 * q + 3] = bfhi(a.y) + bfhi(b.y);
            o[8 * q + 4] = bflo(a.z) + bflo(b.z); o[8 * q + 5] = bfhi(a.z) + bfhi(b.z); o[8 * q + 6] = bflo(a.w) + bflo(b.w); o[8 * q + 7] = bfhi(a.w) + bfhi(b.w); }
#pragma unroll
        for (int k = 0; k < 16; ++k) ss += o[k] * o[k];
        ss += __shfl_xor(ss, 1); ss += __shfl_xor(ss, 2); ss += __shfl_xor(ss, 4);
        const float rs = rsqrtf(ss * (1.0f / 128.0f) + RMS_EPS);
#pragma unroll
        for (int q = 0; q < 2; ++q) { const u4 z = *(const u4*)(SZ + (size_t)r * 1024 + col + 8 * q); const int cc = (lane & 7) * 16 + 8 * q; float v[8];
            const float zz[8] = {bflo(z.x), bfhi(z.x), bflo(z.y), bfhi(z.y), bflo(z.z), bfhi(z.z), bflo(z.w), bfhi(z.w)};
#pragma unroll
            for (int k = 0; k < 8; ++k) v[k] = o[8 * q + k] * rs * F.g_onorm[cc + k] * zz[k];
            *(u4*)(YM + (size_t)r * D + 1024 + col + 8 * q) = (u4){pack2(v[0], v[1]), pack2(v[2], v[3]), pack2(v[4], v[5]), pack2(v[6], v[7])}; }
    }
}


#define XB_TMO      128
#define XB_XCNT(j)  (256  + 64 * (j))
#define XB_XSUB(j)  (1280 + 64 * (j))
#define XB_XGEN(j)  (2304 + 64 * (j))
#define XB_TOP      3328
#define XB_TOPGEN   3392
#define XCD_BAR_WORDS 3456
#define XB_SPIN_CAP (1u << 18)
__device__ __forceinline__ unsigned xb_ld(unsigned* p)              { return __hip_atomic_load(p, __ATOMIC_RELAXED, __HIP_MEMORY_SCOPE_AGENT); }
__device__ __forceinline__ unsigned xb_add(unsigned* p, unsigned v) { return __hip_atomic_fetch_add(p, v, __ATOMIC_RELAXED, __HIP_MEMORY_SCOPE_AGENT); }
__device__ __forceinline__ unsigned xb_xcc_id() { return (unsigned)__builtin_amdgcn_s_getreg((3 << 11) | 20) & 0xFu; }
#define XB_SPIN(cond, bar) do { unsigned _sp = 0; while (cond) { __builtin_amdgcn_s_sleep(1); \
    if ((++_sp & 255u) == 0u) { if (xb_ld(&(bar)[XB_TMO])) break; if (_sp > XB_SPIN_CAP) { atomicAdd(&(bar)[XB_TMO], 1u); break; } } } } while (0)
struct XcdBarrier { unsigned* bar; unsigned x; volatile LAS unsigned* st; };
__device__ __forceinline__ XcdBarrier xcd_barrier_post(unsigned* bar, volatile LAS unsigned* st) {
    XcdBarrier b; b.bar = bar; b.x = xb_xcc_id(); b.st = st;
    if (threadIdx.x == 0) (void)xb_add(&bar[XB_XCNT(b.x)], 1u);
    return b;
}
__device__ __forceinline__ void xcd_barrier_complete(unsigned* bar, unsigned x, unsigned& nloc, unsigned& nx) {
    const unsigned G = gridDim.x * gridDim.y * gridDim.z;
    unsigned sum, cnt, mine, sp = 0u;
    for (;;) {
        sum = 0u; cnt = 0u; mine = 0u;
#pragma unroll
        for (unsigned j = 0; j < 16; ++j) { const unsigned c = xb_ld(&bar[XB_XCNT(j)]); sum += c; cnt += (c > 0u) ? 1u : 0u; mine = (j == x) ? c : mine; }
        if (sum == G) break;
        __builtin_amdgcn_s_sleep(1);
        if ((++sp & 255u) == 0u) { if (xb_ld(&bar[XB_TMO])) break; if (sp > XB_SPIN_CAP) { atomicAdd(&bar[XB_TMO], 1u); break; } }
    }
    nloc = mine > 0u ? mine : 1u; nx = cnt > 0u ? cnt : 1u;
}
__device__ __forceinline__ void xcd_barrier(const XcdBarrier& b) {
    asm volatile("s_waitcnt vmcnt(0)" ::: "memory");
    __syncthreads();
    if (threadIdx.x == 0) {
        unsigned* bar = b.bar;
        __builtin_amdgcn_s_waitcnt(0);
        unsigned nloc = b.st[0], nx = b.st[1];
        if (nloc == 0u) { xcd_barrier_complete(bar, b.x, nloc, nx); b.st[0] = nloc; b.st[1] = nx; }
        const unsigned old = xb_add(&bar[XB_XSUB(b.x)], 1u);
        const unsigned gen = old / nloc;
        if (old + 1u == (gen + 1u) * nloc) {
            __builtin_amdgcn_fence(__ATOMIC_RELEASE, "agent");
            asm volatile("s_waitcnt vmcnt(0)" ::: "memory");
            const unsigned og = xb_add(&bar[XB_TOP], 1u);
            const unsigned tg = og / nx;
            if (og + 1u == (tg + 1u) * nx) xb_add(&bar[XB_TOPGEN], 1u);
            else XB_SPIN(xb_ld(&bar[XB_TOPGEN]) == tg, bar);
            __builtin_amdgcn_fence(__ATOMIC_ACQUIRE, "agent");
            xb_add(&bar[XB_XGEN(b.x)], 1u);
            asm volatile("s_waitcnt vmcnt(0)" ::: "memory");
        } else {
            XB_SPIN(xb_ld(&bar[XB_XGEN(b.x)]) == gen, bar);
            __builtin_amdgcn_fence(__ATOMIC_ACQUIRE, "agent");
            asm volatile("s_waitcnt vmcnt(0)" ::: "memory");
        }
    }
    __syncthreads();
}

constexpr int N_PHASES = 14;
#ifndef ONE_LAUNCH
#define ONE_LAUNCH 0
#endif
__global__ void __launch_bounds__(NT, 2) fwd_kernel(Args args) {
    extern __shared__ __attribute__((aligned(16))) unsigned char lds_raw[];
    cg::grid_group grid = cg::this_grid();
    Frame F;
    F.x_prompt = args.in[0]; F.x_sample = args.in[1]; F.state = args.in[2]; F.cvec = args.in[3]; F.cctx = args.in[4]; F.ada_w = args.in[5]; F.ada_b = args.in[6]; F.npre = args.in[7]; F.npost = args.in[8];
    F.wg = args.in[9]; F.wu = args.in[10]; F.wd = args.in[11]; F.w_in = args.in[12]; F.w_out = args.in[13]; F.hy_conv = args.in[14]; F.hw1 = args.in[15]; F.hb1 = args.in[16]; F.hw2 = args.in[17]; F.hb2 = args.in[18];
    F.hw3 = args.in[19]; F.hdecay = args.in[20]; F.hbias = args.in[21]; F.hnorm = args.in[22]; F.g_conv = args.in[23]; F.g_alog = args.in[24]; F.g_dtb = args.in[25]; F.g_onorm = args.in[26];
    F.out = args.out; F.ws = args.ws; F.lds = (LAS unsigned char*)lds_raw;
    F.tid = threadIdx.x; F.lane = F.tid & 63; F.wave = __builtin_amdgcn_readfirstlane(F.tid >> 6); F.G = gridDim.x;
    const int lo = args.ph_lo, hi = args.ph_hi;
    unsigned* ctl = (unsigned*)(F.ws + WS_CTL);
    LAS int* qslot = (LAS int*)(F.lds + LDS_BYTES - 16);
    const pg8::bf16_t* Hb = (const pg8::bf16_t*)(F.ws + WS_H);
#define IN(k) (lo <= (k) && (k) < hi)
    volatile LAS unsigned* bst = (volatile LAS unsigned*)(F.lds + LDS_BYTES - 32);
    if (F.tid < 2) bst[F.tid] = 0u;
    __syncthreads();
    const XcdBarrier xbar = xcd_barrier_post((unsigned*)(F.ws + WS_BAR), bst);
    if (hi > 1000) grid.sync();
#define SEAM(k) do { if (IN(k) && IN((k) + 1)) xcd_barrier(xbar); } while (0)

    if (IN(0)) { if (blockIdx.x == 0 && F.tid == 0) { ctl[0] = 0u; ctl[1] = 0u; }
        mod_gemv(F); filt_h2(F); conv_inout(F); conv_ffn(F, 0); }
    SEAM(0);
    if (IN(1)) { phase_adaln1(F);
        if (F.G == 256) { if (blockIdx.x < 176) filt_item(F, 336 + (int)blockIdx.x); else if (blockIdx.x < 240) filt_item(F, 704 + (int)blockIdx.x - 176); }
        else for (int it = 336 + blockIdx.x; it < 768; it += F.G) filt_item(F, it); }
    SEAM(1);
    if (IN(2)) { pg8::Gemm g{D, D}; pg8::ZOrder S; S.init(Hb, F.ws + WS_FFGU, MROWS, 2 * FF, nullptr, nullptr, 0, 0, F.G, (int)blockIdx.x);
        pg8::EpiSwiglu E{(pg8::bf16_t*)(F.ws + WS_ACT), FF}; pg8::gemm_phase<pg8::EpiSwiglu, pg8::ZOrder>(F.lds, g, S, E, nullptr);
        if (F.G == 256) { if (blockIdx.x >= 64) { filt_item(F, (int)blockIdx.x - 64); filt_item(F, 512 + (int)blockIdx.x - 64); } } else for (int it = blockIdx.x; it < 192; it += F.G) filt_item(F, it); }
    SEAM(2);
    if (IN(3)) { pg8::Gemm g{FF / 2, FF}; pg8::ZOrder S; S.init(F.ws + WS_ACT, F.ws + WS_FFD, MROWS, D, F.ws + WS_ACT + FF, F.ws + WS_FFD + FF, MROWS, D, F.G, (int)blockIdx.x);
        pg8::EpiBf16<0> E{(pg8::bf16_t*)(F.ws + WS_Y), D, nullptr, 0, 0, (pg8::bf16_t*)(F.ws + WS_Y1), D}; pg8::gemm_phase<pg8::EpiBf16<0>, pg8::ZOrder>(F.lds, g, S, E, nullptr); }
    SEAM(3);
    if (IN(4)) phase_res(F, 0);
    SEAM(4);
    if (IN(5)) { pg8::Gemm g{D, D}; pg8::ZOrder S; S.init(F.ws + WS_WIN, Hb, NHY, MROWS, Hb, F.ws + WS_WIN + (size_t)NHY * D * 2, MROWS, NGD, F.G, (int)blockIdx.x);
        pg8::EpiBf16<0> E{(pg8::bf16_t*)(F.ws + WS_PT), MROWS, nullptr, 0, 0, (pg8::bf16_t*)(F.ws + WS_PG), NGD}; pg8::gemm_phase<pg8::EpiBf16<0>, pg8::ZOrder>(F.lds, g, S, E, nullptr);
        if (F.G == 256) { if (blockIdx.x >= 112) filt_item(F, 192 + (int)blockIdx.x - 112); } else for (int it = 192 + blockIdx.x; it < 336; it += F.G) filt_item(F, it); }
    SEAM(5);
    if (IN(6)) { for (int it = blockIdx.x; it < NITEM_PREP; it += F.G) gdn_prep_item(F, it); }
    SEAM(6);
    if (IN(7)) {
        for (;;) { __syncthreads(); if (F.tid == 0) *qslot = (int)atomicAdd(ctl, 1u); __syncthreads(); const int it = *qslot;
            if (it >= 320 + 1536) break;
            if (it < 320) gdn_chain_item(F, it); else hyena_item(F, it - 320); }
    }
    SEAM(7);
    if (IN(8)) { __syncthreads(); for (int it = blockIdx.x; it < MROWS / 24; it += F.G) hy_out_item(F, it); gdn_out_rows(F); }
    SEAM(8);
    if (IN(9)) { pg8::Gemm g{D / 2, D}; pg8::ZOrder S; S.init(Hb, F.ws + WS_WOUT, MROWS, D, F.ws + WS_H + D, F.ws + WS_WOUT + D, MROWS, D, F.G, (int)blockIdx.x);
        pg8::EpiBf16<0> E{(pg8::bf16_t*)(F.ws + WS_Y), D, nullptr, 0, 0, (pg8::bf16_t*)(F.ws + WS_Y1), D}; pg8::gemm_phase<pg8::EpiBf16<0>, pg8::ZOrder>(F.lds, g, S, E, nullptr); }
    SEAM(9);
    if (IN(10)) { phase_res(F, 1); __syncthreads(); conv_ffn(F, 1); }
    SEAM(10);
    if (IN(11)) { pg8::Gemm g{D, D}; pg8::ZOrder S; S.init(Hb, F.ws + WS_FFGU, MROWS, 2 * FF, nullptr, nullptr, 0, 0, F.G, (int)blockIdx.x);
        pg8::EpiSwiglu E{(pg8::bf16_t*)(F.ws + WS_ACT), FF}; pg8::gemm_phase<pg8::EpiSwiglu, pg8::ZOrder>(F.lds, g, S, E, nullptr); }
    SEAM(11);
    if (IN(12)) { pg8::Gemm g{FF / 2, FF}; pg8::ZOrder S; S.init(F.ws + WS_ACT, F.ws + WS_FFD, MROWS, D, F.ws + WS_ACT + FF, F.ws + WS_FFD + FF, MROWS, D, F.G, (int)blockIdx.x);
        pg8::EpiBf16<0> E{(pg8::bf16_t*)(F.ws + WS_Y), D, nullptr, 0, 0, (pg8::bf16_t*)(F.ws + WS_Y1), D}; pg8::gemm_phase<pg8::EpiBf16<0>, pg8::ZOrder>(F.lds, g, S, E, nullptr); }
    SEAM(12);
    if (IN(13)) phase_res(F, 2);
#undef IN
#undef SEAM
}

extern "C" void kernel_launch(void* const* d_in, const int* in_sizes, int n_in, void* d_out, int out_size, void* d_ws, size_t ws_size, hipStream_t stream) {
    static int grid = 0;
    if (grid == 0) {
        int dev = 0, cus = 0, per_cu = 0;
        if (n_in != 27 || ws_size < WS_END) { fprintf(stderr, "kernel_launch: need 27 inputs and %zu bytes of workspace (got %d, %zu)\n", (size_t)WS_END, n_in, ws_size); grid = -1; return; }
        hipGetDevice(&dev); hipDeviceGetAttribute(&cus, hipDeviceAttributeMultiprocessorCount, dev);
        if (hipFuncSetAttribute((const void*)fwd_kernel, hipFuncAttributeMaxDynamicSharedMemorySize, LDS_BYTES) != hipSuccess) { fprintf(stderr, "kernel_launch: hipFuncSetAttribute failed\n"); grid = -1; return; }
        if (hipOccupancyMaxActiveBlocksPerMultiprocessor(&per_cu, (const void*)fwd_kernel, NT, LDS_BYTES) != hipSuccess || per_cu < 1) { fprintf(stderr, "kernel_launch: occupancy query says %d\n", per_cu); per_cu = 1; }
        (void)hipGetLastError();
        grid = cus * 1;
        fprintf(stderr, "kernel_launch: grid %d (per_cu %d), ws %zu need %zu\n", grid, per_cu, ws_size, (size_t)WS_END);
    }
    if (grid < 0) return;
    (void)hipMemsetAsync((unsigned char*)d_ws + WS_BAR, 0, 16384, stream);
    Args a{};
    for (int i = 0; i < 27; ++i) a.in[i] = (const float*)d_in[i];
    a.out = (float*)d_out; a.ws = (unsigned char*)d_ws;
#if ONE_LAUNCH
    a.ph_lo = 0; a.ph_hi = N_PHASES;
    { void* kargs[] = {&a}; hipError_t e = hipLaunchCooperativeKernel((const void*)fwd_kernel, dim3(grid), dim3(NT), kargs, LDS_BYTES, stream);
      if (e != hipSuccess) fprintf(stderr, "cooperative launch failed: %s\n", hipGetErrorString(e)); }
#else
    for (int p = 0; p < N_PHASES; ++p) { a.ph_lo = p; a.ph_hi = p + 1; void* kargs[] = {&a};
        hipError_t e = hipLaunchCooperativeKernel((const void*)fwd_kernel, dim3(grid), dim3(NT), kargs, LDS_BYTES, stream);
        if (e != hipSuccess) { fprintf(stderr, "launch %d failed: %s\n", p, hipGetErrorString(e)); break; } }
#endif
}
```
